# Optimizing an MI355X kernel written in HIP

```python
import math
import jax, jax.numpy as jnp
from jax import lax
import numpy as np

D_MODEL = 1024
BATCH = 2
SEQ = 8192
DEPTH = 1

DA_HEADS = 4
DA_HEAD_DIM = 128
DA_V_DIM = 2 * DA_HEAD_DIM
DA_COLS = DA_HEADS * DA_V_DIM
MLA_HEADS = 8
MLA_NOPE_DIM = 128
MLA_ROPE_DIM = 64
MLA_QK_DIM = MLA_NOPE_DIM + MLA_ROPE_DIM
MLA_V_DIM = 128
MLA_Q_RANK = 384
MLA_KV_RANK = 256
MLA_COLS = MLA_HEADS * MLA_V_DIM
ROPE_THETA = 10000.0
REL_BUCKETS = 32
REL_MAX_DISTANCE = 128
PEER_HEADS = 8
PEER_N_KEYS = 128
PEER_N_EXPERTS = PEER_N_KEYS * PEER_N_KEYS
PEER_KEY_DIM = 256
PEER_HALF = PEER_KEY_DIM // 2
PEER_TOPK = 16
N_BRANCHES = 2
Q_BLOCK = 128
TOKEN_BLOCK = 128
EPS = 1e-6

DA_Q_COLS = DA_HEADS * 2 * DA_HEAD_DIM
DA_K_COLS = DA_HEADS * 2 * DA_HEAD_DIM
DA_V_COLS = DA_HEADS * DA_V_DIM
GATE_COLS = N_BRANCHES * D_MODEL
IN_SPLITS = (DA_Q_COLS, DA_K_COLS, DA_V_COLS, MLA_Q_RANK, MLA_KV_RANK, MLA_ROPE_DIM, GATE_COLS)
IN_COLS = DA_Q_COLS + DA_K_COLS + DA_V_COLS + MLA_Q_RANK + MLA_KV_RANK + MLA_ROPE_DIM + GATE_COLS

kernel_name = 'hybrid_diffattn_mla_peer_block'


def rms_norm(x, g):
    xf = x.astype(jnp.float32)
    y = xf * lax.rsqrt(jnp.mean(xf * xf, axis=-1, keepdims=True) + EPS)
    return (y * g.astype(jnp.float32)).astype(x.dtype)


def split_cols(t, sizes):
    out, off = [], 0
    for n in sizes:
        out.append(t[..., off:off + n])
        off += n
    return out


def apply_rope(x, cos, sin):
    half = x.shape[-1] // 2
    x1, x2 = x[..., :half], x[..., half:]
    return jnp.concatenate([x1 * cos - x2 * sin, x1 * sin + x2 * cos], axis=-1).astype(x.dtype)


def lambda_init_fn(layer_idx):
    return 0.8 - 0.6 * math.exp(-0.3 * layer_idx)


def t5_bucket(dist):
    n = jnp.maximum(dist, 0)
    max_exact = REL_BUCKETS // 2
    nf = jnp.maximum(n, max_exact).astype(jnp.float32)
    large = max_exact + (jnp.log(nf / max_exact) / math.log(REL_MAX_DISTANCE / max_exact)
                         * (REL_BUCKETS - max_exact)).astype(jnp.int32)
    large = jnp.minimum(large, REL_BUCKETS - 1)
    return jnp.where(n < max_exact, n, large)


def diff_attention(q, k, v, rel_bias, lam):
    seq = q.shape[3]
    scale = DA_HEAD_DIM ** -0.5
    kpos = jnp.arange(seq)

    def block(i):
        start = i * Q_BLOCK
        qb = lax.dynamic_slice_in_dim(q, start, Q_BLOCK, axis=3)
        qpos = start + jnp.arange(Q_BLOCK)
        dist = qpos[:, None] - kpos[None, :]
        bias = jnp.take(rel_bias, t5_bucket(dist), axis=0)
        logits = jnp.einsum('bhmqd,bhmkd->bhmqk', qb, k).astype(jnp.float32) * scale
        logits = logits + jnp.transpose(bias, (2, 0, 1)).astype(jnp.float32)[None, :, None]
        logits = jnp.where(dist >= 0, logits, -jnp.inf)
        p = jax.nn.softmax(logits, axis=-1)
        w = p[:, :, 0] - lam * p[:, :, 1]
        return jnp.einsum('bhqk,bhkd->bhqd', w.astype(v.dtype), v)

    out = lax.map(block, jnp.arange(seq // Q_BLOCK))
    nblk, b, h, qn, dv = out.shape
    return jnp.transpose(out, (1, 0, 3, 2, 4)).reshape(b, seq, h, dv)


def causal_attention(q, k, v):
    seq = q.shape[2]
    scale = q.shape[-1] ** -0.5
    kpos = jnp.arange(seq)

    def block(i):
        start = i * Q_BLOCK
        qb = lax.dynamic_slice_in_dim(q, start, Q_BLOCK, axis=2)
        qpos = start + jnp.arange(Q_BLOCK)
        logits = jnp.einsum('bhqd,bhkd->bhqk', qb, k).astype(jnp.float32) * scale
        logits = jnp.where(kpos[None, :] <= qpos[:, None], logits, -jnp.inf)
        p = jax.nn.softmax(logits, axis=-1)
        return jnp.einsum('bhqk,bhkd->bhqd', p.astype(v.dtype), v)

    out = lax.map(block, jnp.arange(seq // Q_BLOCK))
    nblk, b, h, qn, dv = out.shape
    return jnp.transpose(out, (1, 0, 3, 2, 4)).reshape(b, seq, h * dv)


def peer(h, w_query, sub_keys, u_table, v_table):
    b, s, d = h.shape
    q = jnp.einsum('bsd,dp->bsp', h, w_query).reshape(b, s, PEER_HEADS, 2, PEER_HALF)
    scores = jnp.einsum('bshcp,hcnp->bshcn', q, sub_keys).astype(jnp.float32)
    s1, i1 = lax.top_k(scores[..., 0, :], PEER_TOPK)
    s2, i2 = lax.top_k(scores[..., 1, :], PEER_TOPK)
    cand = (s1[..., :, None] + s2[..., None, :]).reshape(b, s, PEER_HEADS, PEER_TOPK * PEER_TOPK)
    cidx = (i1[..., :, None] * PEER_N_KEYS + i2[..., None, :]).reshape(b, s, PEER_HEADS, PEER_TOPK * PEER_TOPK)
    top, pos = lax.top_k(cand, PEER_TOPK)
    eidx = jnp.take_along_axis(cidx, pos, axis=-1)
    gate = jax.nn.softmax(top, axis=-1).astype(h.dtype)
    nblk = s // TOKEN_BLOCK

    def to_blocks(t):
        return jnp.moveaxis(t.reshape((b, nblk, TOKEN_BLOCK) + t.shape[2:]), 1, 0)

    def block(args):
        hb, ib, gb = args
        u = jnp.take(u_table, ib, axis=0)
        a = jax.nn.gelu(jnp.einsum('btd,bthkd->bthk', hb, u), approximate=False)
        vsel = jnp.take(v_table, ib, axis=0)
        return jnp.einsum('bthk,bthkd->btd', gb * a, vsel)

    out = lax.map(block, (to_blocks(h), to_blocks(eidx), to_blocks(gate)))
    return jnp.moveaxis(out, 0, 1).reshape(b, s, d)


def setup_inputs(seed: int = 0) -> dict:
    key = jax.random.key(seed)
    ks = jax.random.split(key, 26)

    def nrm(k, shape, scale):
        return jax.random.normal(k, shape, jnp.float32) * scale

    def gain(k, shape):
        return 1.0 + 0.02 * jax.random.normal(k, shape, jnp.float32)

    return {
        'x': nrm(ks[0], (BATCH, SEQ, D_MODEL), 1.0),
        'w_in': nrm(ks[1], (DEPTH, D_MODEL, IN_COLS), D_MODEL ** -0.5),
        'attn_norm': gain(ks[2], (DEPTH, D_MODEL)),
        'da_q_norm': gain(ks[3], (DEPTH, DA_HEAD_DIM)),
        'da_k_norm': gain(ks[4], (DEPTH, DA_HEAD_DIM)),
        'da_lambda_q1': nrm(ks[5], (DEPTH, DA_HEAD_DIM), 0.1),
        'da_lambda_k1': nrm(ks[6], (DEPTH, DA_HEAD_DIM), 0.1),
        'da_lambda_q2': nrm(ks[7], (DEPTH, DA_HEAD_DIM), 0.1),
        'da_lambda_k2': nrm(ks[8], (DEPTH, DA_HEAD_DIM), 0.1),
        'da_out_norm': gain(ks[9], (DEPTH, DA_V_DIM)),
        'da_proj': nrm(ks[10], (DEPTH, DA_COLS, D_MODEL), DA_COLS ** -0.5),
        'mla_q_latent_norm': gain(ks[11], (DEPTH, MLA_Q_RANK)),
        'mla_w_uq': nrm(ks[12], (DEPTH, MLA_Q_RANK, MLA_HEADS * MLA_QK_DIM), MLA_Q_RANK ** -0.5),
        'mla_kv_latent_norm': gain(ks[13], (DEPTH, MLA_KV_RANK)),
        'mla_w_ukv': nrm(ks[14], (DEPTH, MLA_KV_RANK, MLA_HEADS * (MLA_NOPE_DIM + MLA_V_DIM)), MLA_KV_RANK ** -0.5),
        'mla_q_norm': gain(ks[15], (DEPTH, MLA_QK_DIM)),
        'mla_k_norm': gain(ks[16], (DEPTH, MLA_QK_DIM)),
        'mla_proj': nrm(ks[17], (DEPTH, MLA_COLS, D_MODEL), MLA_COLS ** -0.5),
        'w_out': nrm(ks[18], (DEPTH, D_MODEL, D_MODEL), D_MODEL ** -0.5),
        'rel_bias': nrm(ks[19], (REL_BUCKETS, DA_HEADS), 0.5),
        'ffn_norm': gain(ks[20], (DEPTH, D_MODEL)),
        'peer_w_query': nrm(ks[21], (DEPTH, D_MODEL, PEER_HEADS * PEER_KEY_DIM), D_MODEL ** -0.5),
        'peer_sub_keys': nrm(ks[22], (DEPTH, PEER_HEADS, 2, PEER_N_KEYS, PEER_HALF), PEER_HALF ** -0.5),
        'peer_u': nrm(ks[23], (DEPTH, PEER_N_EXPERTS, D_MODEL), D_MODEL ** -0.5),
        'peer_v': nrm(ks[24], (DEPTH, PEER_N_EXPERTS, D_MODEL), 0.5),
    }


def reference(x, w_in, attn_norm, da_q_norm, da_k_norm, da_lambda_q1, da_lambda_k1, da_lambda_q2,
              da_lambda_k2, da_out_norm, da_proj, mla_q_latent_norm, mla_w_uq, mla_kv_latent_norm,
              mla_w_ukv, mla_q_norm, mla_k_norm, mla_proj, w_out, rel_bias, ffn_norm, peer_w_query,
              peer_sub_keys, peer_u, peer_v):
    b, s, _ = x.shape
    pos = jnp.arange(s, dtype=jnp.float32)
    inv_freq = ROPE_THETA ** (-jnp.arange(0, MLA_ROPE_DIM, 2, dtype=jnp.float32) / MLA_ROPE_DIM)
    ang = pos[:, None] * inv_freq[None, :]
    cos, sin = jnp.cos(ang), jnp.sin(ang)

    for l in range(DEPTH):
        h = rms_norm(x, attn_norm[l])
        proj = jnp.einsum('bsd,dc->bsc', h, w_in[l])
        qa, ka, va, cq, ckv, kr, gates = split_cols(proj, IN_SPLITS)

        qa = rms_norm(qa.reshape(b, s, DA_HEADS, 2, DA_HEAD_DIM), da_q_norm[l])
        ka = rms_norm(ka.reshape(b, s, DA_HEADS, 2, DA_HEAD_DIM), da_k_norm[l])
        qa = jnp.transpose(qa, (0, 2, 3, 1, 4))
        ka = jnp.transpose(ka, (0, 2, 3, 1, 4))
        va = jnp.transpose(va.reshape(b, s, DA_HEADS, DA_V_DIM), (0, 2, 1, 3))
        lam_init = lambda_init_fn(l)
        lam = (jnp.exp(jnp.sum(da_lambda_q1[l].astype(jnp.float32) * da_lambda_k1[l].astype(jnp.float32)))
               - jnp.exp(jnp.sum(da_lambda_q2[l].astype(jnp.float32) * da_lambda_k2[l].astype(jnp.float32)))
               + lam_init)
        ya = diff_attention(qa, ka, va, rel_bias, lam)
        ya = rms_norm(ya, da_out_norm[l]) * (1.0 - lam_init)
        ya = jnp.einsum('bsc,cd->bsd', ya.reshape(b, s, DA_COLS), da_proj[l])

        cq = rms_norm(cq, mla_q_latent_norm[l])
        qb = jnp.einsum('bsr,rc->bsc', cq, mla_w_uq[l]).reshape(b, s, MLA_HEADS, MLA_QK_DIM)
        q_nope, q_rope = qb[..., :MLA_NOPE_DIM], qb[..., MLA_NOPE_DIM:]
        q_rope = apply_rope(q_rope, cos[:, None, :], sin[:, None, :])
        ckv = rms_norm(ckv, mla_kv_latent_norm[l])
        kv = jnp.einsum('bsr,rc->bsc', ckv, mla_w_ukv[l]).reshape(b, s, MLA_HEADS, MLA_NOPE_DIM + MLA_V_DIM)
        k_nope, vb = kv[..., :MLA_NOPE_DIM], kv[..., MLA_NOPE_DIM:]
        k_rope = apply_rope(kr, cos, sin)
        k_rope = jnp.broadcast_to(k_rope[:, :, None, :], (b, s, MLA_HEADS, MLA_ROPE_DIM))
        qb = rms_norm(jnp.concatenate([q_nope, q_rope], axis=-1), mla_q_norm[l])
        kb = rms_norm(jnp.concatenate([k_nope, k_rope], axis=-1), mla_k_norm[l])
        yb = causal_attention(jnp.transpose(qb, (0, 2, 1, 3)), jnp.transpose(kb, (0, 2, 1, 3)),
                              jnp.transpose(vb, (0, 2, 1, 3)))
        yb = jnp.einsum('bsc,cd->bsd', yb, mla_proj[l])

        g = jax.nn.sigmoid(gates.reshape(b, s, N_BRANCHES, D_MODEL))
        merged = g[:, :, 0] * ya + g[:, :, 1] * yb
        x = x + jnp.einsum('bsd,de->bse', merged, w_out[l])

        h2 = rms_norm(x, ffn_norm[l])
        x = x + peer(h2, peer_w_query[l], peer_sub_keys[l], peer_u[l], peer_v[l])
    return x
```

```cpp
#include <hip/hip_runtime.h>
#include <hip/hip_cooperative_groups.h>
#include <hip/hip_bf16.h>
#include <cstdio>
#include <cstdint>
#include <cmath>
namespace cg = cooperative_groups;

#define LAS __attribute__((address_space(3)))
#define GAS __attribute__((address_space(1)))
typedef unsigned short bf16_t;
typedef short bf16x8 __attribute__((ext_vector_type(8)));
typedef short s16x4 __attribute__((ext_vector_type(4)));
typedef float f32x4 __attribute__((ext_vector_type(4)));
typedef float f32x2 __attribute__((ext_vector_type(2)));
typedef float f32x16 __attribute__((ext_vector_type(16)));
typedef unsigned u32x4 __attribute__((ext_vector_type(4)));
typedef unsigned u32x2 __attribute__((ext_vector_type(2)));
typedef unsigned u32x6 __attribute__((ext_vector_type(6)));
typedef float f32x32 __attribute__((ext_vector_type(32)));

constexpr int NWAVES = 8;
constexpr int BATCH = 2, SEQ = 8192, T = BATCH * SEQ, D = 1024;
constexpr int IN_COLS = 5824;
constexpr float EPS = 1e-6f;
constexpr float LOG2E = 1.4426950408889634f;
constexpr float QSCALE_DA = 0.08838834764831845f * LOG2E;
constexpr float QSCALE_MLA = 0.07216878364870323f * LOG2E;

constexpr size_t MiB = 1u << 20;
constexpr size_t CTL_ZERO_BYTES = 32 * 1024;
constexpr size_t WS_WINA = 1 * MiB, WS_WINB = 7 * MiB, WS_WUQ = 13 * MiB, WS_WUKV = 14 * MiB + 256 * 1024, WS_WDA = 15 * MiB + 256 * 1024,
                 WS_WMLA = 17 * MiB + 256 * 1024, WS_WOUT = 19 * MiB + 256 * 1024, WS_WQ = 21 * MiB + 256 * 1024, WS_KEYS = 25 * MiB + 256 * 1024;
constexpr size_t WS_A = 26 * MiB;
constexpr size_t WS_B = 58 * MiB;
constexpr size_t WS_C = 90 * MiB;
constexpr size_t WS_LAT = WS_C, WS_QM = WS_C + 32 * MiB, WS_KN = WS_C + 80 * MiB, WS_VM = WS_C + 112 * MiB, WS_KRH = WS_C + 144 * MiB;
constexpr size_t WS_QA = WS_C, WS_KA = WS_C + 32 * MiB, WS_VA = WS_C + 64 * MiB, WS_OA = WS_C + 96 * MiB;
constexpr size_t WS_MERGED = WS_C, WS_UT = WS_C + 32 * MiB, WS_VT = WS_C + 64 * MiB, WS_QP = WS_C + 96 * MiB;
constexpr size_t WS_EIDX = WS_B, WS_GATE = WS_B + 8 * MiB;
constexpr size_t WS_UT8 = WS_UT, WS_VT8 = WS_UT + 16 * MiB, WS_SCU = WS_UT + 32 * MiB, WS_SCV = WS_SCU + 64 * 1024;
constexpr size_t WS_SSQL = WS_B;
constexpr size_t WS_END = 256 * MiB;
static_assert(WS_KRH + 16 * MiB <= WS_END && WS_OA + 64 * MiB <= WS_END && WS_QP + 64 * MiB <= WS_END, "ws map");
constexpr int CW_BAR = 4096;

constexpr int RING_BYTES = 155648, LDSCTL_OFF = RING_BYTES, MISC_OFF = LDSCTL_OFF + 320;
constexpr int LDS_BYTES = 160 * 1024;

#define FP6_SETTLE() do { __builtin_amdgcn_sched_barrier(0); asm volatile("s_nop 15\n\ts_nop 3"); __builtin_amdgcn_sched_barrier(0); } while (0)
__device__ __forceinline__ unsigned cvt_pk_bf16(float lo, float hi) { unsigned r; asm volatile("v_cvt_pk_bf16_f32 %0, %1, %2" : "=v"(r) : "v"(lo), "v"(hi)); return r; }
__device__ __forceinline__ float bf_lo(unsigned u) { return __uint_as_float(u << 16); }
__device__ __forceinline__ float bf_hi(unsigned u) { return __uint_as_float(u & 0xffff0000u); }
__device__ __forceinline__ float wave_sum(float v) {
#pragma unroll
    for (int o = 1; o < 64; o <<= 1) v += __shfl_xor(v, o);
    return v;
}
__device__ __forceinline__ float grp_sum8(float v) { v += __shfl_xor(v, 1); v += __shfl_xor(v, 2); v += __shfl_xor(v, 4); return v; }
__device__ __forceinline__ float grp_sum16(float v) { v = grp_sum8(v); v += __shfl_xor(v, 8); return v; }
__device__ __forceinline__ void unpack16(const u32x4& a, const u32x4& b, float (&v)[16]) {
    v[0] = bf_lo(a.x); v[1] = bf_hi(a.x); v[2] = bf_lo(a.y); v[3] = bf_hi(a.y); v[4] = bf_lo(a.z); v[5] = bf_hi(a.z); v[6] = bf_lo(a.w); v[7] = bf_hi(a.w);
    v[8] = bf_lo(b.x); v[9] = bf_hi(b.x); v[10] = bf_lo(b.y); v[11] = bf_hi(b.y); v[12] = bf_lo(b.z); v[13] = bf_hi(b.z); v[14] = bf_lo(b.w); v[15] = bf_hi(b.w);
}
__device__ __forceinline__ void unpack8(const u32x4& a, float (&v)[8]) {
    v[0] = bf_lo(a.x); v[1] = bf_hi(a.x); v[2] = bf_lo(a.y); v[3] = bf_hi(a.y); v[4] = bf_lo(a.z); v[5] = bf_hi(a.z); v[6] = bf_lo(a.w); v[7] = bf_hi(a.w);
}
__device__ __forceinline__ u32x4 pack8f(const float* v) { u32x4 w; w.x = cvt_pk_bf16(v[0], v[1]); w.y = cvt_pk_bf16(v[2], v[3]); w.z = cvt_pk_bf16(v[4], v[5]); w.w = cvt_pk_bf16(v[6], v[7]); return w; }

#define XB_TMO      128
#define XB_XCNT(j)  (256  + 64 * (j))
#define XB_XSUB(j)  (1280 + 64 * (j))
#define XB_XGEN(j)  (2304 + 64 * (j))
#define XB_TOP      3328
#define XB_TOPGEN   3392
#define XCD_BAR_WORDS 3456
#define XB_SPIN_CAP (1u << 18)
__device__ __forceinline__ unsigned xb_ld(unsigned* p)              { return __hip_atomic_load(p, __ATOMIC_RELAXED, __HIP_MEMORY_SCOPE_AGENT); }
__device__ __forceinline__ unsigned xb_add(unsigned* p, unsigned v) { return __hip_atomic_fetch_add(p, v, __ATOMIC_RELAXED, __HIP_MEMORY_SCOPE_AGENT); }
__device__ __forceinline__ unsigned xb_xcc_id() { return (unsigned)__builtin_amdgcn_s_getreg((3 << 11) | 20) & 0xFu; }
#define XB_SPIN(cond, bar) do { unsigned _sp = 0; while (cond) { __builtin_amdgcn_s_sleep(1); \
    if ((++_sp & 255u) == 0u) { if (xb_ld(&(bar)[XB_TMO])) break; if (_sp > XB_SPIN_CAP) { atomicAdd(&(bar)[XB_TMO], 1u); break; } } } } while (0)
struct XcdBarrier { unsigned* bar; unsigned x; volatile LAS unsigned* st; };
__device__ __forceinline__ XcdBarrier xcd_barrier_post(unsigned* bar, volatile LAS unsigned* st, int tid) {
    XcdBarrier b; b.bar = bar; b.x = xb_xcc_id(); b.st = st;
    if (tid == 0) (void)xb_add(&bar[XB_XCNT(b.x)], 1u);
    return b;
}
__device__ __forceinline__ void xcd_barrier_complete(unsigned* bar, unsigned x, unsigned& nloc, unsigned& nx) {
    const unsigned G = gridDim.x * gridDim.y * gridDim.z;
    unsigned sum, cnt, mine, sp = 0u;
    for (;;) {
        sum = 0u; cnt = 0u; mine = 0u;
#pragma unroll
        for (unsigned j = 0; j < 16; ++j) { const unsigned c = xb_ld(&bar[XB_XCNT(j)]); sum += c; cnt += (c > 0u) ? 1u : 0u; mine = (j == x) ? c : mine; }
        if (sum == G) break;
        __builtin_amdgcn_s_sleep(1);
        if ((++sp & 255u) == 0u) { if (xb_ld(&bar[XB_TMO])) break; if (sp > XB_SPIN_CAP) { atomicAdd(&bar[XB_TMO], 1u); break; } }
    }
    nloc = mine > 0u ? mine : 1u; nx = cnt > 0u ? cnt : 1u;
}
__device__ __forceinline__ void xcd_barrier(const XcdBarrier& b, int tid) {
    asm volatile("s_waitcnt vmcnt(0)" ::: "memory");
    __syncthreads();
    if (tid == 0) {
        unsigned* bar = b.bar;
        __builtin_amdgcn_s_waitcnt(0);
        unsigned nloc = b.st[0], nx = b.st[1];
        if (nloc == 0u) { xcd_barrier_complete(bar, b.x, nloc, nx); b.st[0] = nloc; b.st[1] = nx; }
        const unsigned old = xb_add(&bar[XB_XSUB(b.x)], 1u);
        const unsigned gen = old / nloc;
        if (old + 1u == (gen + 1u) * nloc) {
            __builtin_amdgcn_fence(__ATOMIC_RELEASE, "agent");
            asm volatile("s_waitcnt vmcnt(0)" ::: "memory");
            const unsigned og = xb_add(&bar[XB_TOP], 1u);
            const unsigned tg = og / nx;
            if (og + 1u == (tg + 1u) * nx) xb_add(&bar[XB_TOPGEN], 1u);
            else XB_SPIN(xb_ld(&bar[XB_TOPGEN]) == tg, bar);
            __builtin_amdgcn_fence(__ATOMIC_ACQUIRE, "agent");
            xb_add(&bar[XB_XGEN(b.x)], 1u);
            asm volatile("s_waitcnt vmcnt(0)" ::: "memory");
        } else {
            XB_SPIN(xb_ld(&bar[XB_XGEN(b.x)]) == gen, bar);
            __builtin_amdgcn_fence(__ATOMIC_ACQUIRE, "agent");
            asm volatile("s_waitcnt vmcnt(0)" ::: "memory");
        }
    }
    __syncthreads();
}

namespace pg8 {
constexpr int BM = 256, BK = 64, HALF = 128, HTB = HALF * BK * 2, STAGE_BYTES = 8 * HTB, NXCD = 8, WGM = 4;
__host__ __device__ __forceinline__ int lds_byte(int r, int c) { const int st = (r >> 4) * 2 + (c >> 5), rr = r & 15, cc = c & 31, ob = rr * 64 + cc * 2; return st * 1024 + (ob ^ (((ob >> 9) & 1) << 5)); }
__host__ __device__ __forceinline__ void stage_rc(int b, int& R, int& C) { const int st = b / 1024, sb = b % 1024, swz = sb ^ (((sb >> 9) & 1) << 5); R = (st >> 1) * 16 + swz / 64; C = (st & 1) * 32 + (swz % 64) / 2; }
__host__ __device__ __forceinline__ int perm32(int rho) { const int n = rho >> 4, i = rho & 15; return 8 * (i >> 2) + 4 * n + (i & 3); }
struct Unit { int pm, pn; };
struct Gemm { const bf16_t* A; const bf16_t* Bt; int M, N, K, lda, ldb; const bf16_t* A2 = nullptr; int K1 = 0; };
struct StaticOrder {
    int nM, nN, nwg, G, c;
    __device__ void init(int M, int N, int G_, int c_) { nM = M / BM; nN = N / BM; nwg = nM * nN; G = G_; c = c_; }
    __device__ bool next(int i, Unit& u) const {
        const long L = (long)i * G + c; if (L >= nwg) return false;
        int wgid = (int)L; { const int q = nwg / NXCD, r = nwg % NXCD, xcd = wgid % NXCD, off = wgid / NXCD; wgid = (xcd < r ? xcd * (q + 1) : r * (q + 1) + (xcd - r) * q) + off; }
        const int nig = WGM * nN, gid = wgid / nig, fm = gid * WGM, gsz = (nM - fm) < WGM ? (nM - fm) : WGM;
        u.pm = fm + ((wgid % nig) % gsz); u.pn = (wgid % nig) / gsz; return true;
    }
};
struct EpiStore {
    bf16_t* O; int ldc; int split_cols; size_t split_stride; int cut; bf16_t* O2; int ldc2;
    __device__ __forceinline__ void operator()(const f32x4 (&acc)[2][2][4][2], const Unit& u, int wr, int wc, int fr, int fq) const {
        const int row0 = u.pm * BM + wr * 64 + fr; int colt = u.pn * BM; bf16_t* base = O; int ld = ldc;
        if (cut && colt >= cut) { base = O2; ld = ldc2; colt -= cut; }
        else if (split_cols) { const int t = colt / split_cols; base += (size_t)t * split_stride; colt -= t * split_cols; }
        const int col0 = colt + wc * 32 + 8 * fq;
#pragma unroll
        for (int ai = 0; ai < 2; ++ai)
#pragma unroll
            for (int m = 0; m < 4; ++m) { bf16_t* rowp = base + (size_t)(row0 + ai * HALF + m * 16) * ld + col0;
#pragma unroll
                for (int bj = 0; bj < 2; ++bj) { const f32x4 v0 = acc[ai][bj][m][0], v1 = acc[ai][bj][m][1];
                    u32x4 w; w.x = cvt_pk_bf16(v0[0], v0[1]); w.y = cvt_pk_bf16(v0[2], v0[3]); w.z = cvt_pk_bf16(v1[0], v1[1]); w.w = cvt_pk_bf16(v1[2], v1[3]);
                    *(u32x4*)(rowp + bj * HALF) = w; } }
    }
};
struct EpiStoreSS {
    bf16_t* O; int ldc; int cut; bf16_t* O2; int ldc2; float* SS;
    __device__ __forceinline__ void operator()(const f32x4 (&acc)[2][2][4][2], const Unit& u, int wr, int wc, int fr, int fq) const {
        int fr_ = fr, fq_ = fq; asm volatile("" : "+v"(fr_), "+v"(fq_));
        const int row0 = u.pm * BM + wr * 64 + fr_; int colt = u.pn * BM; bf16_t* base = O; int ld = ldc; const bool lat = colt >= cut;
        if (lat) { base = O2; ld = ldc2; colt -= cut; }
        const int col0 = colt + wc * 32 + 8 * fq_;
#pragma unroll
        for (int ai = 0; ai < 2; ++ai)
#pragma unroll
            for (int m = 0; m < 4; ++m) { const int row = row0 + ai * HALF + m * 16; bf16_t* rowp = base + (size_t)row * ld + col0; float ss = 0.f;
#pragma unroll
                for (int bj = 0; bj < 2; ++bj) { const f32x4 v0 = acc[ai][bj][m][0], v1 = acc[ai][bj][m][1];
                    u32x4 w; w.x = cvt_pk_bf16(v0[0], v0[1]); w.y = cvt_pk_bf16(v0[2], v0[3]); w.z = cvt_pk_bf16(v1[0], v1[1]); w.w = cvt_pk_bf16(v1[2], v1[3]);
                    *(u32x4*)(rowp + bj * HALF) = w;
                    ss += (v0[0] * v0[0] + v0[1] * v0[1]) + (v0[2] * v0[2] + v0[3] * v0[3]) + (v1[0] * v1[0] + v1[1] * v1[1]) + (v1[2] * v1[2] + v1[3] * v1[3]); }
                if (lat) { ss += __shfl_xor(ss, 16); ss += __shfl_xor(ss, 32);
                           if (fq_ == 0) SS[(size_t)row * 16 + (colt >> 8) * 4 + wc] = ss; } }
    }
};
struct EpiRowScale {
    bf16_t* O; int ldc; int split_cols; size_t split_stride; const float* SS; int s0, ns; float inv_dim;
    __device__ __forceinline__ void operator()(const f32x4 (&acc)[2][2][4][2], const Unit& u, int wr, int wc, int fr, int fq) const {
        int fr_ = fr, fq_ = fq; asm volatile("" : "+v"(fr_), "+v"(fq_));
        const int row0 = u.pm * BM + wr * 64 + fr_; int colt = u.pn * BM; bf16_t* base = O;
        if (split_cols) { const int t = colt / split_cols; base += (size_t)t * split_stride; colt -= t * split_cols; }
        const int col0 = colt + wc * 32 + 8 * fq_;
#pragma unroll
        for (int ai = 0; ai < 2; ++ai)
#pragma unroll
            for (int m = 0; m < 4; ++m) { const int row = row0 + ai * HALF + m * 16;
                const f32x4* sp = (const f32x4*)(SS + (size_t)row * 16 + s0); f32x4 sv = sp[0]; if (ns > 4) sv += sp[1];
                const float rstd = 1.f / sqrtf(((sv[0] + sv[1]) + (sv[2] + sv[3])) * inv_dim + EPS);
                bf16_t* rowp = base + (size_t)row * ldc + col0;
#pragma unroll
                for (int bj = 0; bj < 2; ++bj) { const f32x4 v0 = acc[ai][bj][m][0] * rstd, v1 = acc[ai][bj][m][1] * rstd;
                    u32x4 w; w.x = cvt_pk_bf16(v0[0], v0[1]); w.y = cvt_pk_bf16(v0[2], v0[3]); w.z = cvt_pk_bf16(v1[0], v1[1]); w.w = cvt_pk_bf16(v1[2], v1[3]);
                    *(u32x4*)(rowp + bj * HALF) = w; } }
    }
};
template <bool ACCUM> struct EpiGate {
    const bf16_t* Gt; int ldg; bf16_t* Tio; int ldc;
    __device__ __forceinline__ void operator()(const f32x4 (&acc)[2][2][4][2], const Unit& u, int wr, int wc, int fr, int fq) const {
        const int row0 = u.pm * BM + wr * 64 + fr; const int col0 = u.pn * BM + wc * 32 + 8 * fq;
#pragma unroll
        for (int ai = 0; ai < 2; ++ai)
#pragma unroll
            for (int m = 0; m < 4; ++m) { const size_t r = (size_t)(row0 + ai * HALF + m * 16);
#pragma unroll
                for (int bj = 0; bj < 2; ++bj) { const f32x4 v0 = acc[ai][bj][m][0], v1 = acc[ai][bj][m][1];
                    const u32x4 gw = *(const u32x4*)(Gt + r * ldg + col0 + bj * HALF);
                    float g[8]; unpack8(gw, g); float o[8];
#pragma unroll
                    for (int e = 0; e < 8; ++e) { const float a = e < 4 ? v0[e] : v1[e - 4]; const float s = __builtin_amdgcn_rcpf(1.f + __builtin_amdgcn_exp2f(-g[e] * LOG2E)); o[e] = s * a; }
                    bf16_t* p = Tio + r * ldc + col0 + bj * HALF;
                    if (ACCUM) { const u32x4 tw = *(const u32x4*)p; float t[8]; unpack8(tw, t);
#pragma unroll
                        for (int e = 0; e < 8; ++e) o[e] += t[e]; }
                    *(u32x4*)p = pack8f(o); } }
    }
};
struct EpiGate2 {
    const bf16_t* Gt; int ldg; bf16_t* To; int ldc;
    static __device__ __forceinline__ float em(float g) { return __builtin_amdgcn_exp2f(-fminf(fmaxf(g, -30.f), 30.f) * LOG2E); }
    __device__ __forceinline__ void mid(f32x4 (&acc)[2][2][4][2], const Unit& u, int wr, int wc, int fr, int fq) const {
        int fr_ = fr, fq_ = fq; asm volatile("" : "+v"(fr_), "+v"(fq_));
        const int row0 = u.pm * BM + wr * 64 + fr_; const int col0 = u.pn * BM + wc * 32 + 8 * fq_;
#pragma unroll
        for (int ai = 0; ai < 2; ++ai)
#pragma unroll
            for (int m = 0; m < 4; ++m) { const size_t r = (size_t)(row0 + ai * HALF + m * 16);
#pragma unroll
                for (int bj = 0; bj < 2; ++bj) {
                    const u32x4 gw0 = *(const u32x4*)(Gt + r * ldg + col0 + bj * HALF), gw1 = *(const u32x4*)(Gt + r * ldg + 1024 + col0 + bj * HALF);
                    float g0[8], g1[8]; unpack8(gw0, g0); unpack8(gw1, g1);
#pragma unroll
                    for (int e = 0; e < 8; ++e) { const float rt = (1.f + em(g1[e])) * __builtin_amdgcn_rcpf(1.f + em(g0[e]));
                        if (e < 4) acc[ai][bj][m][0][e] *= rt; else acc[ai][bj][m][1][e - 4] *= rt; } }
                asm volatile("" ::: "memory"); }
    }
    __device__ __forceinline__ void operator()(const f32x4 (&acc)[2][2][4][2], const Unit& u, int wr, int wc, int fr, int fq) const {
        int fr_ = fr, fq_ = fq; asm volatile("" : "+v"(fr_), "+v"(fq_));
        const int row0 = u.pm * BM + wr * 64 + fr_; const int col0 = u.pn * BM + wc * 32 + 8 * fq_;
#pragma unroll
        for (int ai = 0; ai < 2; ++ai)
#pragma unroll
            for (int m = 0; m < 4; ++m) { const size_t r = (size_t)(row0 + ai * HALF + m * 16);
#pragma unroll
                for (int bj = 0; bj < 2; ++bj) { const f32x4 v0 = acc[ai][bj][m][0], v1 = acc[ai][bj][m][1];
                    const u32x4 gw = *(const u32x4*)(Gt + r * ldg + 1024 + col0 + bj * HALF);
                    float g[8]; unpack8(gw, g); float o[8];
#pragma unroll
                    for (int e = 0; e < 8; ++e) { const float a = e < 4 ? v0[e] : v1[e - 4]; o[e] = a * __builtin_amdgcn_rcpf(1.f + em(g[e])); }
                    *(u32x4*)(To + r * ldc + col0 + bj * HALF) = pack8f(o); } }
    }
};
struct EpiResid {
    const float* X; float* O; int ldc;
    __device__ __forceinline__ void operator()(const f32x4 (&acc)[2][2][4][2], const Unit& u, int wr, int wc, int fr, int fq) const {
        const int row0 = u.pm * BM + wr * 64 + fr; const int col0 = u.pn * BM + wc * 32 + 8 * fq;
#pragma unroll
        for (int ai = 0; ai < 2; ++ai)
#pragma unroll
            for (int m = 0; m < 4; ++m) { const size_t off = (size_t)(row0 + ai * HALF + m * 16) * ldc + col0;
#pragma unroll
                for (int bj = 0; bj < 2; ++bj) {
                    const f32x4 x0 = *(const f32x4*)(X + off + bj * HALF), x1 = *(const f32x4*)(X + off + bj * HALF + 4);
                    *(f32x4*)(O + off + bj * HALF) = x0 + acc[ai][bj][m][0]; *(f32x4*)(O + off + bj * HALF + 4) = x1 + acc[ai][bj][m][1]; } }
    }
};

struct EpiNormQKV {
    bf16_t* O; size_t split_stride; const float* gq; const float* gk; float qscale; LAS float* xl;
    __device__ __forceinline__ void operator()(const f32x4 (&acc)[2][2][4][2], const Unit& u, int wr, int wc, int fr, int fq) const {
        const int row0 = u.pm * BM + wr * 64 + fr; const int colt = u.pn * BM; const int t = colt / 1024; bf16_t* base = O + (size_t)t * split_stride; const int cin = colt - t * 1024;
        const int col0 = cin + wc * 32 + 8 * fq;
        if (t < 2) {
#pragma unroll
            for (int ai = 0; ai < 2; ++ai)
#pragma unroll
                for (int m = 0; m < 4; ++m)
#pragma unroll
                    for (int bj = 0; bj < 2; ++bj) { const f32x4 a = acc[ai][bj][m][0], b = acc[ai][bj][m][1];
                        float s = (a[0] * a[0] + a[1] * a[1]) + (a[2] * a[2] + a[3] * a[3]) + (b[0] * b[0] + b[1] * b[1]) + (b[2] * b[2] + b[3] * b[3]);
                        s += __shfl_xor(s, 16); s += __shfl_xor(s, 32);
                        if (fq == 0) xl[((ai * HALF + wr * 64 + m * 16 + fr) * 2 + bj) * 4 + wc] = s; }
        }
        asm volatile("s_waitcnt lgkmcnt(0)" ::: "memory"); __builtin_amdgcn_s_barrier(); asm volatile("" ::: "memory");
        const float sc = t == 0 ? qscale : 1.f;
        const float* gn = t == 0 ? gq : gk;
        f32x4 g0 = {1.f, 1.f, 1.f, 1.f}, g1 = g0;
        if (t < 2) { g0 = *(const f32x4*)(gn + wc * 32 + 8 * fq); g1 = *(const f32x4*)(gn + wc * 32 + 8 * fq + 4); }
#pragma unroll
        for (int ai = 0; ai < 2; ++ai)
#pragma unroll
            for (int m = 0; m < 4; ++m) { bf16_t* rowp = base + (size_t)(row0 + ai * HALF + m * 16) * 1024 + col0;
#pragma unroll
                for (int bj = 0; bj < 2; ++bj) { f32x4 v0 = acc[ai][bj][m][0], v1 = acc[ai][bj][m][1];
                    if (t < 2) { const f32x4 p = *(const LAS f32x4*)(xl + ((ai * HALF + wr * 64 + m * 16 + fr) * 2 + bj) * 4);
                        const float r = sc / sqrtf(((p[0] + p[1]) + (p[2] + p[3])) * (1.f / 128.f) + EPS); v0 = v0 * r * g0; v1 = v1 * r * g1; }
                    u32x4 w; w.x = cvt_pk_bf16(v0[0], v0[1]); w.y = cvt_pk_bf16(v0[2], v0[3]); w.z = cvt_pk_bf16(v1[0], v1[1]); w.w = cvt_pk_bf16(v1[2], v1[3]);
                    *(u32x4*)(rowp + bj * HALF) = w; }
                asm volatile("" ::: "memory"); }
        asm volatile("s_waitcnt lgkmcnt(0)" ::: "memory"); __builtin_amdgcn_s_barrier(); asm volatile("" ::: "memory");
    }
};

template <class Epi, bool DUAL = false>
__device__ __forceinline__ void gemm_phase(LAS unsigned char* lds, const Gemm g, const StaticOrder& S, const Epi& E, int tid) {
    const int wid = __builtin_amdgcn_readfirstlane(tid >> 6), lane = tid & 63, wr = wid >> 2, wc = wid & 3, fr = lane & 15, fq = lane >> 4;
    const int K = g.K, nt = K / BK;
    unsigned voffA[2], voffB[2];
#pragma unroll
    for (int i = 0; i < 2; ++i) { int R, C; stage_rc(tid * 16 + i * 8192, R, C); const int Rb = (R & ~31) + perm32(R & 31);
        voffA[i] = (unsigned)(R * g.lda + C) * 2u; voffB[i] = (unsigned)(Rb * g.ldb + C) * 2u; }
    const size_t kstep = (size_t)(BK * 2);
    const size_t hA = (size_t)HALF * g.lda * 2, hB = (size_t)HALF * g.ldb * 2;
    const size_t tA = 2 * hA, tB = 2 * hB;
    const unsigned ldsw = (unsigned)wid * 1024u;
    const int aoff = lds_byte(wr * 64 + fr, fq * 8), boff = lds_byte(wc * 32 + fr, fq * 8);
#define PG8_SA(b, h) (((b) * 2 + (h)) * HTB)
#define PG8_SB(b, h) ((4 + (b) * 2 + (h)) * HTB)
#define PG8_STAGE(bufoff, gbase, voff) do { _Pragma("unroll") for (int _i = 0; _i < 2; ++_i) \
        __builtin_amdgcn_global_load_lds((const unsigned*)((const char*)(gbase) + (voff)[_i]), (LAS unsigned*)(lds + (bufoff) + ldsw + _i * 8192), 16, 0, 0); } while (0)
#define PG8_LDA(dst, b, h) do { _Pragma("unroll") for (int m = 0; m < 4; ++m) _Pragma("unroll") for (int k = 0; k < 2; ++k) dst[m][k] = *(const LAS bf16x8*)(lds + PG8_SA(b, h) + aoff + m * 2048 + k * 1024); } while (0)
#define PG8_LDB(dst, b, h) do { _Pragma("unroll") for (int n = 0; n < 2; ++n) _Pragma("unroll") for (int k = 0; k < 2; ++k) dst[n][k] = *(const LAS bf16x8*)(lds + PG8_SB(b, h) + boff + n * 2048 + k * 1024); } while (0)
#define PG8_MMA(ai, bj, At, Bt) do { __builtin_amdgcn_s_setprio(1); _Pragma("unroll") for (int m = 0; m < 4; ++m) _Pragma("unroll") for (int n = 0; n < 2; ++n) _Pragma("unroll") for (int k = 0; k < 2; ++k) \
        acc[ai][bj][m][n] = __builtin_amdgcn_mfma_f32_16x16x32_bf16(Bt[n][k], At[m][k], acc[ai][bj][m][n], 0, 0, 0); __builtin_amdgcn_s_setprio(0); } while (0)
#define PG8_WAIT_V(n) asm volatile("s_waitcnt vmcnt(" #n ")" ::: "memory")
#define PG8_WAIT_L(n) asm volatile("s_waitcnt lgkmcnt(" #n ")" ::: "memory")
#define PG8_BAR __builtin_amdgcn_s_barrier()
#define PG8_SCHED __builtin_amdgcn_sched_barrier(0)
    Unit cur, nxt; int ui = 0;
    if (!S.next(0, cur)) return;
    f32x4 acc[2][2][4][2];
#pragma unroll
    for (int a = 0; a < 2; ++a)
#pragma unroll
        for (int b = 0; b < 2; ++b)
#pragma unroll
            for (int m = 0; m < 4; ++m)
#pragma unroll
                for (int n = 0; n < 2; ++n) acc[a][b][m][n] = (f32x4){0.f, 0.f, 0.f, 0.f};
    bf16x8 At[4][2], B0[2][2], B1[2][2];
    const char* cA = (const char*)g.A + (size_t)cur.pm * tA; const char* cB = (const char*)g.Bt + (size_t)cur.pn * tB;
    const int nt1 = DUAL ? g.K1 / BK : 0;
    const char* cA2 = DUAL ? (const char*)g.A2 + (size_t)cur.pm * tA : nullptr;
#define PG8_AAT(s) ((DUAL && (s) >= nt1) ? cA2 + (size_t)((s) - nt1) * kstep : cA + (size_t)(s) * kstep)
    PG8_STAGE(PG8_SB(0, 0), cB, voffB); PG8_STAGE(PG8_SB(0, 1), cB + hB, voffB); PG8_STAGE(PG8_SA(0, 0), cA, voffA); PG8_STAGE(PG8_SA(0, 1), cA + hA, voffA);
    if (wr == 1) PG8_BAR;
    PG8_WAIT_V(2); PG8_BAR;
    PG8_STAGE(PG8_SB(1, 0), cB + kstep, voffB); PG8_STAGE(PG8_SA(1, 0), cA + kstep, voffA); PG8_STAGE(PG8_SB(1, 1), cB + hB + kstep, voffB);
    PG8_WAIT_V(6); PG8_BAR;
    for (;;) {
        const bool has_next = S.next(ui + 1, nxt);
        const char* nA = has_next ? (const char*)g.A + (size_t)nxt.pm * tA : cA; const char* nB = has_next ? (const char*)g.Bt + (size_t)nxt.pn * tB : cB;
#pragma unroll 1
        for (int half_ = 0; half_ < (DUAL ? 2 : 1); ++half_) {
        if constexpr (DUAL) { if (half_ == 1) E.mid(acc, cur, wr, wc, fr, fq); }
        const int tbeg_ = (DUAL && half_ == 1) ? nt1 : 0, tend_ = (DUAL && half_ == 0) ? nt1 : nt;
#pragma unroll 1
        for (int t = tbeg_; t < tend_; t += 2) {
            const bool last = (t == nt - 2);
            const char* a1 = PG8_AAT(t + 1);
            const char* a2 = last ? nA : PG8_AAT(t + 2); const char* b2 = last ? nB : cB + (size_t)(t + 2) * kstep;
            const char* a3 = a2 + kstep; const char* b3 = b2 + kstep;
            PG8_LDB(B0, 0, 0); PG8_LDB(B1, 0, 1); PG8_SCHED; PG8_LDA(At, 0, 0); PG8_STAGE(PG8_SA(1, 1), a1 + hA, voffA);
            PG8_WAIT_V(8); PG8_WAIT_L(0); PG8_BAR; PG8_MMA(0, 0, At, B0); PG8_MMA(0, 1, At, B1); PG8_BAR; PG8_SCHED;
            PG8_LDA(At, 0, 1); PG8_STAGE(PG8_SB(0, 0), b2, voffB); PG8_STAGE(PG8_SB(0, 1), b2 + hB, voffB); PG8_STAGE(PG8_SA(0, 0), a2, voffA);
            PG8_WAIT_V(8); PG8_WAIT_L(0); PG8_BAR; PG8_MMA(1, 0, At, B0); PG8_MMA(1, 1, At, B1); PG8_BAR; PG8_SCHED;
            PG8_LDB(B0, 1, 0); PG8_LDB(B1, 1, 1); PG8_SCHED; PG8_LDA(At, 1, 0); PG8_STAGE(PG8_SA(0, 1), a2 + hA, voffA);
            PG8_WAIT_V(8); PG8_WAIT_L(0); PG8_BAR; PG8_MMA(0, 0, At, B0); PG8_MMA(0, 1, At, B1); PG8_BAR; PG8_SCHED;
            PG8_LDA(At, 1, 1); PG8_STAGE(PG8_SB(1, 0), b3, voffB); PG8_STAGE(PG8_SB(1, 1), b3 + hB, voffB); PG8_STAGE(PG8_SA(1, 0), a3, voffA);
            PG8_WAIT_V(8); PG8_WAIT_L(0); PG8_BAR; PG8_MMA(1, 0, At, B0); PG8_MMA(1, 1, At, B1); PG8_BAR; PG8_SCHED;
        }
        }
        if (wr == 0) PG8_BAR;
        E(acc, cur, wr, wc, fr, fq);
        if (!has_next) break;
#pragma unroll
        for (int a = 0; a < 2; ++a)
#pragma unroll
            for (int b = 0; b < 2; ++b)
#pragma unroll
                for (int m = 0; m < 4; ++m)
#pragma unroll
                    for (int n = 0; n < 2; ++n) acc[a][b][m][n] = (f32x4){0.f, 0.f, 0.f, 0.f};
        cur = nxt; cA = nA; cB = nB; ++ui; if constexpr (DUAL) cA2 = (const char*)g.A2 + (size_t)cur.pm * tA;
        if (wr == 1) PG8_BAR;
    }
    PG8_WAIT_V(0);
    PG8_BAR;
#undef PG8_AAT
#undef PG8_SA
#undef PG8_SB
#undef PG8_STAGE
#undef PG8_LDA
#undef PG8_LDB
#undef PG8_MMA
#undef PG8_WAIT_V
#undef PG8_WAIT_L
#undef PG8_BAR
#undef PG8_SCHED
}
}

namespace att {
constexpr int NW = 8, QBLK = 32, KVBLK = 64, QB = NW * QBLK;
constexpr int SHM_V = KVBLK * 128 * 2;
constexpr float THR2 = 11.5f;
#define KSWZ(row, colB) ((row) * 256 + ((colB) ^ (((row) & 7) << 4)))
#define KRSWZ(row, c) ((row) * 128 + ((((c) ^ (((row) >> 1) & 7))) << 4))
#define SBAR() __builtin_amdgcn_sched_barrier(0)
__device__ __forceinline__ int v_st(int k, int c) { const int kk = (k & ~0xC) | ((k & 4) << 1) | ((k & 8) >> 1); return ((kk >> 3) * 4 + (c >> 5)) * 512 + ((kk & 7) * 32 + (c & 31)) * 2; }
__device__ __forceinline__ int v_rd_base(int lane) { return ((lane & 3) << 3) | (((lane >> 2) & 3) << 6) | (((lane >> 4) & 1) << 5) | (((lane >> 5) & 1) << 8); }
constexpr int v_rd_off(int d0, int ks, int half) { return d0 * 512 + ks * 4096 + half * 2048; }
__device__ __forceinline__ int crow(int r, int hi) { return (r & 3) + 8 * (r >> 2) + 4 * hi; }
__device__ __forceinline__ unsigned cvtpk(float lo, float hi) { unsigned r; asm volatile("v_cvt_pk_bf16_f32 %0, %1, %2" : "=v"(r) : "v"(lo), "v"(hi)); return r; }

template <int DQK> struct Cfg {
    static constexpr int SHM_K = KVBLK * DQK * 2;
    static constexpr int OFF_K = 0, OFF_V = 2 * SHM_K, OFF_WS = OFF_V + 3 * SHM_V, OFF_BT = OFF_WS + NW * 64 * 4, OFF_QX = OFF_BT + 512 * 4;
    static constexpr int NQR = (DQK == 192 ? 8 : 8), NQX = DQK / 16 - NQR, QXW = NQX * 1024, LDS_NEED = OFF_QX + NW * QXW;
};
struct BlockRef { const bf16_t* Q; const bf16_t* K; const bf16_t* K2; const bf16_t* V; bf16_t* O; int P0; };
struct Seam { bf16x8 qr[8]; };

__device__ __forceinline__ void mask_tile(f32x16& p0, f32x16& p1, int dq) {
#pragma unroll
    for (int r = 0; r < 16; ++r) { const int c = (r & 3) + 8 * (r >> 2);
        p0[r] += __int_as_float(((dq - c) >> 31) & (int)0xFF800000);
        p1[r] += __int_as_float(((dq - c - 32) >> 31) & (int)0xFF800000); }
}
__device__ __forceinline__ void bias_tile(f32x16& p0, f32x16& p1, int dq, const float* bt) {
    const float* b = bt + (dq + 256 - 59);
#pragma unroll
    for (int r = 0; r < 16; ++r) { const int c = (r & 3) + 8 * (r >> 2);
        p0[r] += b[59 - c]; p1[r] += b[27 - c]; }
}
__device__ __forceinline__ void partialSM(f32x16& p0, f32x16& p1, float& m_reg, float& mn, float& alpha) {
    float pmax = p0[0];
#pragma unroll
    for (int r = 1; r < 16; ++r) pmax = fmaxf(pmax, p0[r]);
#pragma unroll
    for (int r = 0; r < 16; ++r) pmax = fmaxf(pmax, p1[r]);
    { auto rr = __builtin_amdgcn_permlane32_swap(__float_as_uint(pmax), __float_as_uint(pmax), false, false);
      pmax = fmaxf(__uint_as_float(rr[0]), __uint_as_float(rr[1])); }
    if (__builtin_expect(__all((pmax - m_reg) <= THR2), 1)) { mn = m_reg; alpha = 1.f; }
    else { mn = fmaxf(m_reg, pmax); alpha = __builtin_amdgcn_exp2f(m_reg - mn); m_reg = mn; }
#pragma unroll
    for (int r = 0; r < 16; ++r) p0[r] = p0[r] - mn;
#pragma unroll
    for (int r = 0; r < 16; ++r) p1[r] = p1[r] - mn;
#pragma unroll
    for (int r = 0; r < 16; ++r) p0[r] = __builtin_amdgcn_exp2f(p0[r]);
}
__device__ __forceinline__ void partialSMf(f32x16& p0, f32x16& p1, float negB) {
#pragma unroll
    for (int r = 0; r < 16; ++r) p0[r] = __builtin_amdgcn_exp2f(p0[r] + negB);
#pragma unroll
    for (int r = 0; r < 16; ++r) p1[r] = p1[r] + negB;
}
__device__ __forceinline__ void finishSM(f32x16& p0, f32x16& p1, float alpha, float& l_reg, bf16x8& pa0, bf16x8& pa1, bf16x8& pa2, bf16x8& pa3) {
#pragma unroll
    for (int r = 0; r < 16; ++r) p1[r] = __builtin_amdgcn_exp2f(p1[r]);
    float ps = 0;
#pragma unroll
    for (int r = 0; r < 16; ++r) ps += p0[r];
#pragma unroll
    for (int r = 0; r < 16; ++r) ps += p1[r];
    { auto rr = __builtin_amdgcn_permlane32_swap(__float_as_uint(ps), __float_as_uint(ps), false, false);
      ps = __uint_as_float(rr[0]) + __uint_as_float(rr[1]); }
    l_reg = l_reg * alpha + ps;
#define PK4(P, B_, OUT) do { unsigned a0 = cvtpk(P[B_+0], P[B_+1]), a1 = cvtpk(P[B_+2], P[B_+3]);                          \
        unsigned b0 = cvtpk(P[B_+4], P[B_+5]), b1 = cvtpk(P[B_+6], P[B_+7]);                                             \
        auto r0 = __builtin_amdgcn_permlane32_swap(a0, b0, false, false); auto r1 = __builtin_amdgcn_permlane32_swap(a1, b1, false, false); \
        u32x4 w = {r0[0], r1[0], r0[1], r1[1]}; OUT = *reinterpret_cast<bf16x8*>(&w); } while (0)
    PK4(p0, 0, pa0); PK4(p0, 8, pa1); PK4(p1, 0, pa2); PK4(p1, 8, pa3);
#undef PK4
}
template <int DQK, int KB>
__device__ __forceinline__ void qkt(f32x16& p0, f32x16& p1, const char* K_lds, const char* qx, int r32, int hi, const bf16x8* qr) {
    constexpr int SHM_K = Cfg<DQK>::SHM_K, NQR = Cfg<DQK>::NQR;
    p0 = f32x16{}; p1 = f32x16{};
    const char* kb[4];
#pragma unroll
    for (int dd = 0; dd < 4; ++dd) kb[dd] = K_lds + KB * SHM_K + KSWZ(r32, (dd * 16 + hi * 8) * 2);
#pragma unroll
    for (int d0 = 0; d0 < 8; ++d0) { const char* a = kb[d0 & 3] + (d0 >> 2) * 128;
        bf16x8 b0 = *reinterpret_cast<const bf16x8*>(a);
        bf16x8 b1 = *reinterpret_cast<const bf16x8*>(a + 32 * 256);
        bf16x8 q; if (d0 < NQR) q = qr[d0]; else q = *reinterpret_cast<const bf16x8*>(qx + (d0 - NQR) * 1024);
        p0 = __builtin_amdgcn_mfma_f32_32x32x16_bf16(b0, q, p0, 0, 0, 0);
        p1 = __builtin_amdgcn_mfma_f32_32x32x16_bf16(b1, q, p1, 0, 0, 0); }
    if constexpr (DQK == 192) {
#pragma unroll
        for (int dd = 0; dd < 4; ++dd) { const char* a = K_lds + KB * SHM_K + 16384 + KRSWZ(r32, dd * 2 + hi);
            bf16x8 b0 = *reinterpret_cast<const bf16x8*>(a);
            bf16x8 b1 = *reinterpret_cast<const bf16x8*>(a + 32 * 128);
            const bf16x8 q = *reinterpret_cast<const bf16x8*>(qx + (8 + dd - NQR) * 1024);
            p0 = __builtin_amdgcn_mfma_f32_32x32x16_bf16(b0, q, p0, 0, 0, 0);
            p1 = __builtin_amdgcn_mfma_f32_32x32x16_bf16(b1, q, p1, 0, 0, 0); }
    }
}
__device__ __forceinline__ void pv_tile(f32x16* o, int vb0, bf16x8 pa0, bf16x8 pa1, bf16x8 pa2, bf16x8 pa3) {
#define TRRD(dst, off) asm volatile("ds_read_b64_tr_b16 %0, %1 offset:%2" : "=&v"(dst) : "v"(vb0), "i"(off) : "memory")
#define PV_D0(d0) do { s16x4 l0, l1, l2, l3, h0, h1, h2, h3; constexpr int b_ = v_rd_off(d0, 0, 0); \
        TRRD(l0, b_); TRRD(h0, b_ + 2048); TRRD(l1, b_ + 4096); TRRD(h1, b_ + 6144); TRRD(l2, b_ + 8192); TRRD(h2, b_ + 10240); TRRD(l3, b_ + 12288); TRRD(h3, b_ + 14336); \
        asm volatile("s_waitcnt lgkmcnt(0)" ::: "memory"); SBAR();   \
        o[d0] = __builtin_amdgcn_mfma_f32_32x32x16_bf16(pa0, (bf16x8){l0[0], l0[1], l0[2], l0[3], h0[0], h0[1], h0[2], h0[3]}, o[d0], 0, 0, 0);   \
        o[d0] = __builtin_amdgcn_mfma_f32_32x32x16_bf16(pa1, (bf16x8){l1[0], l1[1], l1[2], l1[3], h1[0], h1[1], h1[2], h1[3]}, o[d0], 0, 0, 0);   \
        o[d0] = __builtin_amdgcn_mfma_f32_32x32x16_bf16(pa2, (bf16x8){l2[0], l2[1], l2[2], l2[3], h2[0], h2[1], h2[2], h2[3]}, o[d0], 0, 0, 0);   \
        o[d0] = __builtin_amdgcn_mfma_f32_32x32x16_bf16(pa3, (bf16x8){l3[0], l3[1], l3[2], l3[3], h3[0], h3[1], h3[2], h3[3]}, o[d0], 0, 0, 0); } while (0)
    PV_D0(0); PV_D0(1); PV_D0(2); PV_D0(3);
#undef PV_D0
#undef TRRD
}

__device__ __forceinline__ const bf16_t* uni_ptr(const bf16_t* p) {
    const unsigned long long v = (unsigned long long)p; const unsigned lo = __builtin_amdgcn_readfirstlane((unsigned)v), hi = __builtin_amdgcn_readfirstlane((unsigned)(v >> 32));
    return (const bf16_t*)(const GAS bf16_t*)(((unsigned long long)hi << 32) | lo); }
#define LD8B(base, off32) (*reinterpret_cast<const bf16x8*>((const char*)(base) + (size_t)(unsigned)(off32)))
#define VMW() asm volatile("s_waitcnt vmcnt(0)" ::: "memory")
#define VMWN(n) asm volatile("s_waitcnt vmcnt(%0)" :: "i"(n) : "memory")
#define SLOAD(Kp, K2p, Vp, k0) do { const bf16_t* vt_ = uni_ptr((Vp) + (size_t)(k0) * LDV); const bf16_t* kt_ = uni_ptr((Kp) + (size_t)(k0) * LDK);      \
        S.st_v0 = LD8B(vt_, ovk); S.st_v1 = LD8B(vt_ + 32 * LDV, ovk);                                                           \
        S.st_k0 = LD8B(kt_, okk); S.st_k1 = LD8B(kt_ + 32 * LDK, okk);                                                           \
        if constexpr (DQK == 192) S.st_k2 = LD8B(uni_ptr((K2p) + (size_t)(k0) * LDK2), ok2); } while (0)
#define SWRITE_K(bf) do { *(bf16x8*)(K_lds + (bf) * SHM_K + kws) = S.st_k0; *(bf16x8*)(K_lds + (bf) * SHM_K + kws + 32 * 256) = S.st_k1;   \
        if constexpr (DQK == 192) *(bf16x8*)(K_lds + (bf) * SHM_K + 16384 + krs) = S.st_k2; } while (0)
#define SWRITE_V(bf) do { char* vs_ = V_lds + (bf) * SHM_V; *(bf16x8*)(vs_ + vst0) = S.st_v0; *(bf16x8*)(vs_ + vst1) = S.st_v1; } while (0)
#define QLOAD(R) do { const bf16_t* qb_ = uni_ptr((R).Q + (size_t)(wid * QBLK) * LDQ);                                                \
        _Pragma("unroll") for (int d0 = 0; d0 < Cfg<DQK>::NQR; ++d0) S.qr[d0] = LD8B(qb_ + d0 * 16, oq); } while (0)
#define QX_FILL(R) do { if constexpr (Cfg<DQK>::NQX > 0) { const bf16_t* qb_ = uni_ptr((R).Q + (size_t)(wid * QBLK) * LDQ); bf16x8 qxr[Cfg<DQK>::NQX];  \
        _Pragma("unroll") for (int dd = 0; dd < Cfg<DQK>::NQX; ++dd) qxr[dd] = LD8B(qb_ + (Cfg<DQK>::NQR + dd) * 16, oq);                \
        VMW(); _Pragma("unroll") for (int dd = 0; dd < Cfg<DQK>::NQX; ++dd) *(bf16x8*)(qx + dd * 1024) = qxr[dd]; } } while (0)

template <int DQK, int LDQ, int LDK, int LDK2, int LDV>
__device__ __forceinline__ void attn_prime(const BlockRef& cur, char* lds, Seam& S, int tid_in) {
    const int tid = tid_in;
    const int wid = __builtin_amdgcn_readfirstlane(tid >> 6), lane = tid & 63, r32 = lane & 31, hi = lane >> 5;
    const unsigned oq = (unsigned)(r32 * LDQ + hi * 8) * 2u;
    char* qx = lds + Cfg<DQK>::OFF_QX + wid * Cfg<DQK>::QXW + lane * 16;
    QX_FILL(cur);
    QLOAD(cur);
    __syncthreads();
}
template <int DQK, bool BIAS, int LDQ, int LDK, int LDK2, int LDV, int LDO, class MK>
__device__ __forceinline__ void attn_block(const BlockRef& cur, int next_idx, const MK& mk, char* lds, Seam& S, int tid_in, float negB) {
    constexpr int SHM_K = Cfg<DQK>::SHM_K;
    const int tid = tid_in;
    const int wid = __builtin_amdgcn_readfirstlane(tid >> 6), lane = tid & 63, r32 = lane & 31, hi = lane >> 5;
    const int NT = (cur.P0 + QB - 1) / KVBLK + 1;
    const int qlo = cur.P0 + wid * QBLK, qm = qlo + r32 - 4 * hi;
    char* V_lds = lds + Cfg<DQK>::OFF_V; char* K_lds = lds + Cfg<DQK>::OFF_K;
    float* ws = (float*)(lds + Cfg<DQK>::OFF_WS) + wid * 64; float* li_l = ws, * al_l = ws + 32;
    const float* bt = (const float*)(lds + Cfg<DQK>::OFF_BT);
    char* qx = lds + Cfg<DQK>::OFF_QX + wid * Cfg<DQK>::QXW + lane * 16;
    float l_reg = 0; f32x16 o[4] = {};
    const unsigned oq = (unsigned)(r32 * LDQ + hi * 8) * 2u;
    const int vb0 = (int)(uintptr_t)V_lds + v_rd_base(lane);
    unsigned ks0, ks1, kr0, vs0, vs1;
    { const int ra = 8 * wid + (lane >> 4), rb = ra + 4; ks0 = (unsigned)(ra * LDK + ((lane & 15) ^ (ra & 7)) * 8) * 2u; ks1 = (unsigned)(rb * LDK + ((lane & 15) ^ (rb & 7)) * 8) * 2u;
      const int rr = 8 * wid + (lane >> 3); kr0 = (unsigned)(rr * LDK2 + ((lane & 7) ^ ((rr >> 1) & 7)) * 8) * 2u;
#define VSRC(sp) ({ const int sidx = 2 * (sp) + (lane >> 5), kk = (sidx >> 2) * 8 + ((lane & 31) >> 2), k = (kk & ~0xC) | ((kk & 4) << 1) | ((kk & 8) >> 1); (unsigned)(k * LDV + (sidx & 3) * 32 + (lane & 3) * 8) * 2u; })
      vs0 = VSRC(2 * wid); vs1 = VSRC(2 * wid + 1);
#undef VSRC
    }
    const bf16_t* Kh = cur.K; const bf16_t* K2h = cur.K2; const bf16_t* Vh = cur.V;
#define DMA_TILE(t, kslot, vslot) do { const char* kt_ = (const char*)uni_ptr(Kh + (size_t)((t) * KVBLK) * LDK); const char* vt_ = (const char*)uni_ptr(Vh + (size_t)((t) * KVBLK) * LDV);     \
        LAS char* kd_ = (LAS char*)K_lds + (kslot) * SHM_K; LAS char* vd_ = (LAS char*)V_lds + (vslot) * SHM_V + wid * 2048;                                                             \
        __builtin_amdgcn_global_load_lds((const unsigned*)(kt_ + ks0), (LAS unsigned*)(kd_ + wid * 2048), 16, 0, 0);                                                                       \
        __builtin_amdgcn_global_load_lds((const unsigned*)(kt_ + ks1), (LAS unsigned*)(kd_ + wid * 2048 + 1024), 16, 0, 0);                                                                \
        if constexpr (DQK == 192) { const char* k2_ = (const char*)uni_ptr(K2h + (size_t)((t) * KVBLK) * LDK2);                                                                           \
            __builtin_amdgcn_global_load_lds((const unsigned*)(k2_ + kr0), (LAS unsigned*)(kd_ + 16384 + wid * 1024), 16, 0, 0); }                                                          \
        __builtin_amdgcn_global_load_lds((const unsigned*)(vt_ + vs0), (LAS unsigned*)(vd_), 16, 0, 0);                                                                                    \
        __builtin_amdgcn_global_load_lds((const unsigned*)(vt_ + vs1), (LAS unsigned*)(vd_ + 1024), 16, 0, 0); } while (0)
#define RESC(a) do { if (__any((a) < 1.f)) { if (hi == 0) al_l[r32] = (a); asm volatile("s_waitcnt lgkmcnt(0)" ::: "memory");              \
                     for (int d_ = 0; d_ < 4; ++d_) for (int r = 0; r < 16; ++r) o[d_][r] *= al_l[crow(r, hi)]; } } while (0)
#define KBASE(t) ((t) * KVBLK)
#define MASKT(P0_, P1_, t) do { const int kb_ = KBASE(t); if constexpr (BIAS) { if (kb_ + KVBLK - 1 + 128 > qlo) bias_tile(P0_, P1_, qm - kb_, bt); } \
                                else { if (kb_ + KVBLK - 1 > qlo) mask_tile(P0_, P1_, qm - kb_); } } while (0)
    f32x16 pA0, pA1, pB0, pB1; bf16x8 pa0, pa1, pa2, pa3;
    DMA_TILE(0, 0, 0);
    __syncthreads();
    DMA_TILE(1, 1, 1);
    asm volatile("s_sleep 4" ::: "memory");
    SBAR(); qkt<DQK, 0>(pA0, pA1, K_lds, qx, r32, hi, S.qr);
    MASKT(pA0, pA1, 0); partialSMf(pA0, pA1, negB);
    __syncthreads();
    int rs = 0, wsl = 2;
#define STEP(PX0, PX1, PY0, PY1, t, KB, ORD) do {                                                              \
        if ((t) + 1 < NT) DMA_TILE((t) + 1, (KB) ^ 1, wsl);                                                                   \
        SBAR();                                                                                                               \
        if (ORD == 0) { qkt<DQK, KB>(PX0, PX1, K_lds, qx, r32, hi, S.qr); finishSM(PY0, PY1, 1.f, l_reg, pa0, pa1, pa2, pa3); SBAR();      \
                        pv_tile(o, vb0 + rs * SHM_V, pa0, pa1, pa2, pa3); MASKT(PX0, PX1, (t)); partialSMf(PX0, PX1, negB); }   \
        else { finishSM(PY0, PY1, 1.f, l_reg, pa0, pa1, pa2, pa3); SBAR();                                                    \
               qkt<DQK, KB>(PX0, PX1, K_lds, qx, r32, hi, S.qr); MASKT(PX0, PX1, (t)); partialSMf(PX0, PX1, negB); SBAR();      \
               pv_tile(o, vb0 + rs * SHM_V, pa0, pa1, pa2, pa3); }                                                 \
        __syncthreads();                                                                                                      \
        rs = rs == 2 ? 0 : rs + 1; wsl = wsl == 2 ? 0 : wsl + 1; } while (0)
    for (int t = 1; t + 1 < NT; t += 2) { STEP(pB0, pB1, pA0, pA1, t, 1, 0); STEP(pA0, pA1, pB0, pB1, t + 1, 0, 0); }
    STEP(pB0, pB1, pA0, pA1, NT - 1, 1, 0);
    finishSM(pB0, pB1, 1.f, l_reg, pa0, pa1, pa2, pa3); SBAR(); pv_tile(o, vb0 + rs * SHM_V, pa0, pa1, pa2, pa3);
    int nj_ = next_idx; asm volatile("" : "+s"(nj_)); const BlockRef nxt = mk(nj_);
    SBAR(); QLOAD(nxt); SBAR();
    if (hi == 0) li_l[r32] = l_reg; asm volatile("s_waitcnt lgkmcnt(0)" ::: "memory");
    float rli[16];
#pragma unroll
    for (int r = 0; r < 16; ++r) rli[r] = __builtin_amdgcn_rcpf(li_l[crow(r, hi)]);
    bf16_t* Ow = cur.O + (size_t)(wid * QBLK) * LDO;
#pragma unroll
    for (int r = 0; r < 16; ++r) { const int orow = crow(r, hi);
#pragma unroll
        for (int d0 = 0; d0 < 4; ++d0) { const float v = o[d0][r] * rli[r];
            const float vn = __shfl_xor(v, 1);
            if ((r32 & 1) == 0) *(unsigned*)(Ow + (size_t)orow * LDO + d0 * 32 + r32) = cvtpk(v, vn); } }
    QX_FILL(nxt);
    __syncthreads();
#undef RESC
#undef KBASE
#undef MASKT
#undef STEP
#undef DMA_TILE
}
#undef LD8B
#undef VMW
#undef VMWN
#undef SLOAD
#undef SWRITE_K
#undef SWRITE_V
#undef QLOAD
#undef QX_FILL
}

namespace daw {
using att::crow; using att::cvtpk;
constexpr int NW = 8, QBLK = 32, KVB = 32, QB = 256;
constexpr int SHM_V = KVB * 256 * 2, SHM_K = KVB * 128 * 2;
constexpr int OFF_K = 3 * SHM_V, OFF_WS = OFF_K + 2 * SHM_K, OFF_BT = OFF_WS + NW * 64 * 4, OFF_QL = OFF_BT + 512 * 4, LDS_NEED = OFF_QL + NW * 8192;
__device__ __forceinline__ int v_st2(int k, int c) { const int kk = (k & ~0xC) | ((k & 4) << 1) | ((k & 8) >> 1); return ((kk >> 3) * 8 + (c >> 5)) * 512 + ((kk & 7) * 32 + (c & 31)) * 2; }
struct BlockRef { const bf16_t* Q; const bf16_t* K; const bf16_t* V; bf16_t* O; int P0; };
struct Seam { bf16x8 st_v0, st_v1, st_k0; };
__device__ __forceinline__ void bias_tile1(f32x16& p0, int dq, const float* bt) {
    const float* b = bt + (dq + 256 - 27);
#pragma unroll
    for (int r = 0; r < 16; ++r) { const int c = (r & 3) + 8 * (r >> 2); p0[r] += b[27 - c]; }
}
__device__ __forceinline__ void partialSM1(f32x16& p0, float negB) {
#pragma unroll
    for (int r = 0; r < 8; ++r) p0[r] = __builtin_amdgcn_exp2f(p0[r] + negB);
}
__device__ __forceinline__ void finishSM1(f32x16& p0, float negB, float& l_reg, bf16x8& pa0, bf16x8& pa1) {
#pragma unroll
    for (int r = 8; r < 16; ++r) p0[r] = __builtin_amdgcn_exp2f(p0[r] + negB);
    float ps = 0;
#pragma unroll
    for (int r = 0; r < 16; ++r) ps += p0[r];
    l_reg += ps;
#define PK4(P, B_, OUT) do { unsigned a0 = cvtpk(P[B_+0], P[B_+1]), a1 = cvtpk(P[B_+2], P[B_+3]);                          \
        unsigned b0 = cvtpk(P[B_+4], P[B_+5]), b1 = cvtpk(P[B_+6], P[B_+7]);                                             \
        auto r0 = __builtin_amdgcn_permlane32_swap(a0, b0, false, false); auto r1 = __builtin_amdgcn_permlane32_swap(a1, b1, false, false); \
        u32x4 w = {r0[0], r1[0], r0[1], r1[1]}; OUT = *reinterpret_cast<bf16x8*>(&w); } while (0)
    PK4(p0, 0, pa0); PK4(p0, 8, pa1);
#undef PK4
}
constexpr int NQRD = 4;
template <int KB>
__device__ __forceinline__ void qkt1(f32x16& p0, const char* K_lds, const char* ql, int r32, int hi, const bf16x8* qreg) {
    p0 = f32x16{};
    const char* kb[4];
#pragma unroll
    for (int dd = 0; dd < 4; ++dd) kb[dd] = K_lds + KB * SHM_K + KSWZ(r32, (dd * 16 + hi * 8) * 2);
#pragma unroll
    for (int d0 = 0; d0 < 8; ++d0) { const char* a = kb[d0 & 3] + (d0 >> 2) * 128;
        const bf16x8 b0 = *reinterpret_cast<const bf16x8*>(a);
        bf16x8 q; if (d0 < NQRD) q = qreg[d0]; else q = *reinterpret_cast<const bf16x8*>(ql + d0 * 1024);
        p0 = __builtin_amdgcn_mfma_f32_32x32x16_bf16(b0, q, p0, 0, 0, 0); }
}
__device__ __forceinline__ void pv_tile1(f32x16* o, int vb, bf16x8 pa0, bf16x8 pa1) {
#define TRRD(dst, off) asm volatile("ds_read_b64_tr_b16 %0, %1 offset:%2" : "=&v"(dst) : "v"(vb), "i"(off) : "memory")
#define PV_D0(d0) do { s16x4 l0, l1, h0, h1; constexpr int b_ = (d0) * 512; \
        TRRD(l0, b_); TRRD(h0, b_ + 4096); TRRD(l1, b_ + 8192); TRRD(h1, b_ + 12288); \
        asm volatile("s_waitcnt lgkmcnt(0)" ::: "memory"); SBAR();   \
        o[d0] = __builtin_amdgcn_mfma_f32_32x32x16_bf16(pa0, (bf16x8){l0[0], l0[1], l0[2], l0[3], h0[0], h0[1], h0[2], h0[3]}, o[d0], 0, 0, 0);   \
        o[d0] = __builtin_amdgcn_mfma_f32_32x32x16_bf16(pa1, (bf16x8){l1[0], l1[1], l1[2], l1[3], h1[0], h1[1], h1[2], h1[3]}, o[d0], 0, 0, 0); } while (0)
    PV_D0(0); PV_D0(1); PV_D0(2); PV_D0(3); PV_D0(4); PV_D0(5); PV_D0(6); PV_D0(7);
#undef PV_D0
#undef TRRD
}
#define LD8B(base, off32) (*reinterpret_cast<const bf16x8*>((const char*)(base) + (size_t)(unsigned)(off32)))
#define VMW() asm volatile("s_waitcnt vmcnt(0)" ::: "memory")
#define SLOAD(Kp, Vp, k0) do { const bf16_t* vt_ = att::uni_ptr((Vp) + (size_t)(k0) * LDV); const bf16_t* kt_ = att::uni_ptr((Kp) + (size_t)(k0) * LDK);      \
        S.st_v0 = LD8B(vt_, ovk); S.st_v1 = LD8B(vt_ + 128, ovk); S.st_k0 = LD8B(kt_, okk); } while (0)
#define SWRITE_K(bf) do { *(bf16x8*)(K_lds + (bf) * SHM_K + kws) = S.st_k0; } while (0)
#define SWRITE_V(bf) do { char* vs_ = V_lds + (bf) * SHM_V; *(bf16x8*)(vs_ + vst0) = S.st_v0; *(bf16x8*)(vs_ + vst1) = S.st_v1; } while (0)
#define Q_FILL(R) do { const bf16_t* qb_ = att::uni_ptr((R).Q + (size_t)(wid * QBLK) * LDQ); bf16x8 qxr[8];                              \
        _Pragma("unroll") for (int dd = 0; dd < 8; ++dd) qxr[dd] = LD8B(qb_ + dd * 16, oq);                                            \
        VMW(); _Pragma("unroll") for (int dd = 0; dd < 8; ++dd) *(bf16x8*)(ql + dd * 1024) = qxr[dd]; } while (0)

template <int LDQ, int LDK, int LDV>
__device__ __forceinline__ void prime(const BlockRef& cur, char* lds, int tid) {
    const int wid = __builtin_amdgcn_readfirstlane(tid >> 6), lane = tid & 63, r32 = lane & 31, hi = lane >> 5;
    const unsigned oq = (unsigned)(r32 * LDQ + hi * 8) * 2u;
    char* ql = lds + OFF_QL + wid * 8192 + lane * 16;
    Q_FILL(cur);
    __syncthreads();
}
template <int LDQ, int LDK, int LDV, int LDO, class MK>
__device__ __forceinline__ void block(const BlockRef& cur, int next_idx, const MK& mk, char* lds, int tid, float negB) {
    const int wid = __builtin_amdgcn_readfirstlane(tid >> 6), lane = tid & 63, r32 = lane & 31, hi = lane >> 5;
    const int NT = (cur.P0 + QB) / KVB;
    const int qlo = cur.P0 + wid * QBLK, qm = qlo + r32 - 4 * hi;
    char* V_lds = lds; char* K_lds = lds + OFF_K;
    float* ws = (float*)(lds + OFF_WS) + wid * 64; float* li_l = ws;
    const float* bt = (const float*)(lds + OFF_BT);
    char* ql = lds + OFF_QL + wid * 8192 + lane * 16;
    float l_reg = 0; f32x16 o[8] = {};
    const unsigned oq = (unsigned)(r32 * LDQ + hi * 8) * 2u;
    const int vb0 = (int)(uintptr_t)V_lds + att::v_rd_base(lane);
    unsigned ksrc, vsrc0, vsrc1;
    { const int r = 4 * wid + (lane >> 4), c16 = (lane & 15) ^ (r & 7); ksrc = (unsigned)(r * LDK + c16 * 8) * 2u;
#define VSRC(sp) ({ const int sidx = 2 * (sp) + (lane >> 5), kk = (sidx >> 3) * 8 + ((lane & 31) >> 2), k = (kk & ~0xC) | ((kk & 4) << 1) | ((kk & 8) >> 1); (unsigned)(k * LDV + (sidx & 7) * 32 + (lane & 3) * 8) * 2u; })
      vsrc0 = VSRC(2 * wid); vsrc1 = VSRC(2 * wid + 1);
#undef VSRC
    }
    const bf16_t* Kh = cur.K; const bf16_t* Vh = cur.V;
#define DMA_TILE(t, kslot, vslot) do { const char* kt_ = (const char*)att::uni_ptr(Kh + (size_t)((t) * KVB) * LDK); const char* vt_ = (const char*)att::uni_ptr(Vh + (size_t)((t) * KVB) * LDV);   \
        LAS unsigned* kd_ = (LAS unsigned*)((LAS char*)K_lds + (kslot) * SHM_K + wid * 1024); LAS unsigned* vd_ = (LAS unsigned*)((LAS char*)V_lds + (vslot) * SHM_V + wid * 2048);        \
        __builtin_amdgcn_global_load_lds((const unsigned*)(kt_ + ksrc), kd_, 16, 0, 0);                                                                                                   \
        __builtin_amdgcn_global_load_lds((const unsigned*)(vt_ + vsrc0), vd_, 16, 0, 0);                                                                                                  \
        __builtin_amdgcn_global_load_lds((const unsigned*)(vt_ + vsrc1), (LAS unsigned*)((LAS char*)vd_ + 1024), 16, 0, 0); } while (0)
#define KBASE(t) ((t) * KVB)
#define MASKT(P0_, t) do { const int kb_ = KBASE(t); if (kb_ + KVB - 1 + 128 > qlo) bias_tile1(P0_, qm - kb_, bt); } while (0)
    f32x16 pA0, pB0; bf16x8 pa0, pa1;
    bf16x8 qreg[NQRD];
#pragma unroll
    for (int d0 = 0; d0 < NQRD; ++d0) qreg[d0] = *reinterpret_cast<const bf16x8*>(ql + d0 * 1024);
    DMA_TILE(0, 0, 0);
    __syncthreads();
    DMA_TILE(1, 1, 1);
    asm volatile("s_sleep 4" ::: "memory");
    SBAR(); qkt1<0>(pA0, K_lds, ql, r32, hi, qreg);
    MASKT(pA0, 0); partialSM1(pA0, negB);
    __syncthreads();
    int rs = 0, wsl = 2;
#define STEP(PX0, PY0, t, KB, ORD) do {                                                                                       \
        if ((t) + 1 < NT) DMA_TILE((t) + 1, (KB) ^ 1, wsl);                                                                   \
        SBAR();                                                                                                               \
        if (ORD == 0) { qkt1<KB>(PX0, K_lds, ql, r32, hi, qreg); finishSM1(PY0, negB, l_reg, pa0, pa1); SBAR();                      \
                        pv_tile1(o, vb0 + rs * SHM_V, pa0, pa1); MASKT(PX0, (t)); partialSM1(PX0, negB); }                    \
        else          { finishSM1(PY0, negB, l_reg, pa0, pa1); SBAR(); qkt1<KB>(PX0, K_lds, ql, r32, hi, qreg);                      \
                        MASKT(PX0, (t)); partialSM1(PX0, negB); SBAR(); pv_tile1(o, vb0 + rs * SHM_V, pa0, pa1); }            \
        __syncthreads();                                                                                                      \
        rs = rs == 2 ? 0 : rs + 1; wsl = wsl == 2 ? 0 : wsl + 1; } while (0)
    {
        for (int t = 1; t + 1 < NT; t += 2) { STEP(pB0, pA0, t, 1, 0); STEP(pA0, pB0, t + 1, 0, 0); }
        STEP(pB0, pA0, NT - 1, 1, 0);
    }
    finishSM1(pB0, negB, l_reg, pa0, pa1); SBAR(); pv_tile1(o, vb0 + rs * SHM_V, pa0, pa1);
    int nj_ = next_idx; asm volatile("" : "+s"(nj_)); const BlockRef nxt = mk(nj_);
    { auto rr = __builtin_amdgcn_permlane32_swap(__float_as_uint(l_reg), __float_as_uint(l_reg), false, false); l_reg = __uint_as_float(rr[0]) + __uint_as_float(rr[1]); }
    if (hi == 0) li_l[r32] = l_reg; asm volatile("s_waitcnt lgkmcnt(0)" ::: "memory");
    float rli[16];
#pragma unroll
    for (int r = 0; r < 16; ++r) rli[r] = __builtin_amdgcn_rcpf(li_l[crow(r, hi)]);
    bf16_t* Ow = cur.O + (size_t)(wid * QBLK) * LDO;
#pragma unroll
    for (int r = 0; r < 16; ++r) { const int orow = crow(r, hi);
#pragma unroll
        for (int d0 = 0; d0 < 8; ++d0) { const float v = o[d0][r] * rli[r];
            const float vn = __shfl_xor(v, 1);
            if ((r32 & 1) == 0) *(unsigned*)(Ow + (size_t)orow * LDO + d0 * 32 + r32) = cvtpk(v, vn); } }
    Q_FILL(nxt);
    __syncthreads();
#undef KBASE
#undef MASKT
#undef STEP
#undef DMA_TILE
}
#undef LD8B
#undef VMW
#undef SLOAD
#undef SWRITE_K
#undef SWRITE_V
#undef Q_FILL
}

struct Args { const float* in[25]; float* out; unsigned char* ws; };
enum { I_X = 0, I_WIN, I_ATTN_NORM, I_DA_QN, I_DA_KN, I_LQ1, I_LK1, I_LQ2, I_LK2, I_DA_ON, I_DA_PROJ, I_MLA_QLN, I_MLA_WUQ, I_MLA_KVLN, I_MLA_WUKV,
       I_MLA_QN, I_MLA_KN, I_MLA_PROJ, I_WOUT, I_RELB, I_FFN_NORM, I_PEER_WQ, I_PEER_KEYS, I_PEER_U, I_PEER_V };

struct Ctx {
    LAS unsigned char* lds; int tid, lane, wave, vcu, G, gw, NGW;
};

__device__ __forceinline__ void tr_item(const float* W, int K, int N, int src0, bf16_t* WT, int dst0, int nblk, LAS float* scr, int item, int lane, int ldw, int kofs, const float* kgain) {
    const int kb = item / nblk, nb = item % nblk, k0 = 64 * kb, n0 = 32 * nb;
#pragma unroll 8
    for (int i = 0; i < 32; ++i) { const int kk = 2 * i + (lane >> 5); scr[kk * 33 + (lane & 31)] = W[(size_t)(k0 + kk) * N + src0 + n0 + (lane & 31)]; }
    asm volatile("s_waitcnt lgkmcnt(0)" ::: "memory");
    const int c = lane & 7;
    f32x4 g0 = {1.f, 1.f, 1.f, 1.f}, g1 = g0;
    if (kgain) { g0 = *(const f32x4*)(kgain + k0 + 8 * c); g1 = *(const f32x4*)(kgain + k0 + 8 * c + 4); }
#pragma unroll
    for (int j = 0; j < 4; ++j) { const int n = (lane >> 3) + 8 * j; const LAS float* s = scr + (8 * c) * 33 + n;
        u32x4 o; o.x = cvt_pk_bf16(s[0 * 33] * g0[0], s[1 * 33] * g0[1]); o.y = cvt_pk_bf16(s[2 * 33] * g0[2], s[3 * 33] * g0[3]); o.z = cvt_pk_bf16(s[4 * 33] * g1[0], s[5 * 33] * g1[1]); o.w = cvt_pk_bf16(s[6 * 33] * g1[2], s[7 * 33] * g1[3]);
        *(u32x4*)(WT + (size_t)(dst0 + n0 + n) * ldw + kofs + k0 + 8 * c) = o; }
    asm volatile("s_waitcnt lgkmcnt(0)" ::: "memory");
}
__device__ __forceinline__ void tr_seg(const Ctx& C, LAS float* scr, const float* W, int K, int N, int src0, int width, bf16_t* WT, int dst0, int& base, int ldw = 0, int kofs = 0, const float* kgain = nullptr) {
    if (ldw == 0) ldw = K;
    const int nblk = width / 32, nitems = (K / 64) * nblk;
    int first = (C.gw - base) % C.NGW; if (first < 0) first += C.NGW;
    for (int it = first; it < nitems; it += C.NGW) tr_item(W, K, N, src0, WT, dst0, nblk, scr, it, C.lane, ldw, kofs, kgain);
    base = (base + nitems) % C.NGW;
}
__device__ __forceinline__ void rms_row_f32_to_bf16(const float* xrow, const float* gain, bf16_t* orow, int lane) {
    const f32x4* xr = (const f32x4*)xrow + lane; const f32x4* gr = (const f32x4*)gain + lane;
    f32x4 v[4]; float s = 0.f;
#pragma unroll
    for (int j = 0; j < 4; ++j) { v[j] = xr[64 * j]; s += (v[j].x * v[j].x + v[j].y * v[j].y) + (v[j].z * v[j].z + v[j].w * v[j].w); }
    const float rstd = 1.f / sqrtf(wave_sum(s) * (1.f / 1024.f) + EPS);
    u32x2* o8 = (u32x2*)orow + lane;
#pragma unroll
    for (int j = 0; j < 4; ++j) { const f32x4 g = gr[64 * j]; u32x2 w; w.x = cvt_pk_bf16(v[j].x * rstd * g.x, v[j].y * rstd * g.y); w.y = cvt_pk_bf16(v[j].z * rstd * g.z, v[j].w * rstd * g.w); o8[64 * j] = w; }
}
__device__ __forceinline__ float rope_invf(int i) { return exp2f(-(float)i * (13.287712379549449f / 32.f)); }

__device__ __forceinline__ unsigned vsel(unsigned long long m, unsigned a, unsigned b) { unsigned r; asm("v_cndmask_b32 %0, %1, %2, %3" : "=v"(r) : "v"(b), "v"(a), "s"(m)); return r; }
#define CE_DESC(a, b) do { const float _h = fmaxf(a, b); b = fminf(a, b); a = _h; } while (0)
__device__ __forceinline__ void topk_insert(float (&top)[16], float v) {
#pragma unroll
    for (int j = 0; j < 16; ++j) { const float h = fmaxf(top[j], v); v = fminf(top[j], v); top[j] = h; }
}
__device__ __forceinline__ void bitonic_sort16_desc(float (&a)[16]) {
#pragma unroll
    for (int d = 8; d >= 1; d >>= 1)
#pragma unroll
        for (int i = 0; i < 16; ++i) if ((i & d) == 0) CE_DESC(a[i], a[i + d]);
}
__device__ __forceinline__ void full_sort16_desc(float (&a)[16]) {
#define L_(i, j) CE_DESC(a[i], a[j]);
    L_(0,13) L_(1,12) L_(2,15) L_(3,14) L_(4,8) L_(5,6) L_(7,11) L_(9,10)
    L_(0,5) L_(1,7) L_(2,9) L_(3,4) L_(6,13) L_(8,14) L_(10,15) L_(11,12)
    L_(0,1) L_(2,3) L_(4,5) L_(6,8) L_(7,9) L_(10,11) L_(12,13) L_(14,15)
    L_(0,2) L_(1,3) L_(4,10) L_(5,11) L_(6,7) L_(8,9) L_(12,14) L_(13,15)
    L_(1,2) L_(3,12) L_(4,6) L_(5,7) L_(8,10) L_(9,11) L_(13,14)
    L_(1,4) L_(2,6) L_(5,8) L_(7,10) L_(9,13) L_(11,14)
    L_(2,4) L_(3,6) L_(9,12) L_(11,13)
    L_(3,5) L_(6,8) L_(7,9) L_(10,12)
    L_(3,4) L_(5,6) L_(7,8) L_(9,10) L_(11,12)
    L_(6,7) L_(8,9)
#undef L_
}
__device__ __forceinline__ void merge_top16(float (&a)[16], const float (&b)[16]) {
#pragma unroll
    for (int j = 0; j < 16; ++j) a[j] = fmaxf(a[j], b[15 - j]);
    bitonic_sort16_desc(a);
}
__device__ __forceinline__ void half_top16(const f32x16 (&acc)[4], int hi, float (&top)[16]) {
    float g[4][16];
#pragma unroll
    for (int tl = 0; tl < 4; ++tl) {
#pragma unroll
        for (int r = 0; r < 16; ++r) { const unsigned key = (unsigned)(tl * 32 + (r & 3) + 8 * (r >> 2)) + 4u * (unsigned)hi;
            g[tl][r] = __uint_as_float((__float_as_uint(acc[tl][r]) & 0xFFFFFF80u) | key); }
        full_sort16_desc(g[tl]); }
    merge_top16(g[0], g[1]); merge_top16(g[2], g[3]); merge_top16(g[0], g[2]);
    float oth[16]; const unsigned long long mhi = __ballot(hi != 0);
#pragma unroll
    for (int j = 0; j < 16; ++j) { auto rr = __builtin_amdgcn_permlane32_swap(__float_as_uint(g[0][j]), __float_as_uint(g[0][j]), false, false);
        oth[j] = __uint_as_float(vsel(mhi, rr[0], rr[1])); top[j] = g[0][j]; }
    merge_top16(top, oth);
}
__device__ __forceinline__ unsigned sel16(const float (&a)[16], unsigned i) {
    const unsigned long long m8 = __ballot((i & 8u) != 0u), m4 = __ballot((i & 4u) != 0u), m2 = __ballot((i & 2u) != 0u), m1 = __ballot((i & 1u) != 0u);
    unsigned v[8];
#pragma unroll
    for (int j = 0; j < 8; ++j) v[j] = vsel(m8, __float_as_uint(a[j + 8]), __float_as_uint(a[j]));
#pragma unroll
    for (int j = 0; j < 4; ++j) v[j] = vsel(m4, v[j + 4], v[j]);
#pragma unroll
    for (int j = 0; j < 2; ++j) v[j] = vsel(m2, v[j + 2], v[j]);
    return vsel(m1, v[1], v[0]) & 127u;
}
__device__ __forceinline__ void p7_topk(const Ctx& C, const bf16_t* QP, const bf16_t* KEYS, int* EIDX, float* GATE) {
    const int lane = C.lane, r32 = lane & 31, hi = lane >> 5;
    const bool split = (C.G % 8) == 0;
    const int h0 = split ? (C.vcu & 7) : 0, hstep = split ? 8 : 1;
    const int wg_i = split ? (C.vcu >> 3) : C.vcu, wg_n = split ? (C.G >> 3) : C.G;
    for (int h = h0; h < 8; h += hstep) {
        __syncthreads();
        { const bf16_t* kp = KEYS + (size_t)h * 2 * 128 * 128;
#pragma unroll
          for (int i = 0; i < 8; ++i) { const int ch = C.tid + i * 512; const int row = ch >> 4, c16 = ch & 15;
              const u32x4 v = *(const u32x4*)(kp + (size_t)row * 128 + c16 * 8);
              *(LAS u32x4*)(C.lds + row * 256 + ((c16 ^ (row & 7)) << 4)) = v; } }
        __syncthreads();
    bf16x8 bq[16];
#define P7_QLOAD(tl_) do { const bf16_t* qp_ = QP + (size_t)((tl_) * 32 + r32) * 2048 + h * 256 + hi * 8;               \
        _Pragma("unroll") for (int ks = 0; ks < 8; ++ks) { bq[ks] = *(const bf16x8*)(qp_ + ks * 16); bq[8 + ks] = *(const bf16x8*)(qp_ + 128 + ks * 16); } } while (0)
    for (int tile = wg_i * 8 + C.wave; tile < T / 32; tile += wg_n * 8) {
        const int t0 = tile * 32;
        float s1[16], s2[16];
        P7_QLOAD(tile);
#pragma unroll
        for (int c = 0; c < 2; ++c) {
            f32x16 acc[4] = {};
#pragma unroll
            for (int ks = 0; ks < 8; ++ks) {
#pragma unroll
                for (int tl = 0; tl < 4; ++tl) { const int row = c * 128 + tl * 32 + r32;
                    const bf16x8 a = *(const LAS bf16x8*)(C.lds + row * 256 + (((ks * 2 + hi) ^ (row & 7)) << 4));
                    acc[tl] = __builtin_amdgcn_mfma_f32_32x32x16_bf16(a, bq[c * 8 + ks], acc[tl], 0, 0, 0); }
                if (ks & 1) __builtin_amdgcn_sched_barrier(0);
            }
            if (c == 0) half_top16(acc, hi, s1); else half_top16(acc, hi, s2);
        }
        float s1v[16], s2v[16];
#pragma unroll
        for (int j = 0; j < 16; ++j) { s1v[j] = __uint_as_float(__float_as_uint(s1[j]) & 0xFFFFFF80u); s2v[j] = __uint_as_float(__float_as_uint(s2[j]) & 0xFFFFFF80u); }
#define CAND(i, j) __uint_as_float((__float_as_uint(s1v[i] + s2v[j]) & 0xFFFFFF00u) | (unsigned)((i) * 16 + (j)))
        float top[16], y1[16], y2[16];
#pragma unroll
        for (int j = 0; j < 16; ++j) top[j] = CAND(0, j);
#pragma unroll
        for (int j = 0; j < 8; ++j) { y1[j] = CAND(1, j); y1[15 - j] = CAND(8 + j, 0); }
        bitonic_sort16_desc(y1);
        y2[0] = CAND(2, 0); y2[1] = CAND(2, 1); y2[2] = CAND(2, 2); y2[3] = CAND(2, 3); y2[4] = CAND(2, 4);
        y2[5] = CAND(3, 0); y2[6] = CAND(3, 1); y2[7] = CAND(3, 2); y2[8] = CAND(3, 3);
        y2[9] = CAND(4, 0); y2[10] = CAND(4, 1); y2[11] = CAND(4, 2);
        y2[12] = CAND(5, 0); y2[13] = CAND(5, 1); y2[14] = CAND(6, 0); y2[15] = CAND(6, 1);
        full_sort16_desc(y2);
        merge_top16(top, y1); merge_top16(top, y2);
        topk_insert(top, CAND(7, 0)); topk_insert(top, CAND(7, 1));
#undef CAND
        float w[16]; float sum = 0.f; const float v0 = __uint_as_float(__float_as_uint(top[0]) & 0xFFFFFF00u);
#pragma unroll
        for (int k = 0; k < 16; ++k) { const float v = __uint_as_float(__float_as_uint(top[k]) & 0xFFFFFF00u); w[k] = __expf(v - v0); sum += w[k]; }
        const float inv = 1.f / sum;
        const unsigned long long mhi = __ballot(hi != 0);
        int eo[8]; float go[8];
#pragma unroll
        for (int k = 0; k < 8; ++k) { const unsigned tv = vsel(mhi, __float_as_uint(top[k + 8]), __float_as_uint(top[k])); const float wv = __uint_as_float(vsel(mhi, __float_as_uint(w[k + 8]), __float_as_uint(w[k])));
            const unsigned id = tv & 255u;
            eo[k] = (int)(sel16(s1, id >> 4) * 128u + sel16(s2, id & 15u)); go[k] = wv * inv; }
        const size_t ob = ((size_t)(t0 + r32) * 8 + h) * 16 + hi * 8;
        *(int4*)(EIDX + ob) = make_int4(eo[0], eo[1], eo[2], eo[3]); *(int4*)(EIDX + ob + 4) = make_int4(eo[4], eo[5], eo[6], eo[7]);
        *(float4*)(GATE + ob) = make_float4(go[0], go[1], go[2], go[3]); *(float4*)(GATE + ob + 4) = make_float4(go[4], go[5], go[6], go[7]);
    }
#undef P7_QLOAD
    }
}

__device__ __forceinline__ void p8_gather(const Ctx& C, const bf16_t* H2, const unsigned char* UT8, const unsigned char* VT8, const float* SCU, const float* SCV,
                                          const int* EIDX, const float* GATE, float* out) {
    const int lane = C.lane, l5 = lane & 31, half = lane >> 5;
    const unsigned long long m32 = __ballot((lane & 32) != 0), m16 = __ballot((lane & 16) != 0), m8 = __ballot((lane & 8) != 0);
    LAS int* LISTE = (LAS int*)(C.lds + C.wave * 2048) + half * 128; LAS float* LISTG = (LAS float*)(C.lds + C.wave * 2048 + 1024) + half * 128;
    for (int tp = C.gw; tp < T / 2; tp += C.NGW) {
        const int t = 2 * tp + half;
        f32x32 hf;
        { const bf16_t* hp = H2 + (size_t)t * 1024 + 32 * l5;
          const u32x4 h0 = *(const u32x4*)hp, h1 = *(const u32x4*)(hp + 8), h2_ = *(const u32x4*)(hp + 16), h3 = *(const u32x4*)(hp + 24);
          float a[16], b[16]; unpack16(h0, h1, a); unpack16(h2_, h3, b);
#pragma unroll
          for (int e = 0; e < 16; ++e) { hf[e] = a[e]; hf[16 + e] = b[e]; } }
        int ev[4]; float gv[4];
#pragma unroll
        for (int k = 0; k < 4; ++k) { ev[k] = EIDX[(size_t)t * 128 + 32 * k + l5]; gv[k] = GATE[(size_t)t * 128 + 32 * k + l5]; }
        f32x32 acc;
#pragma unroll
        for (int e = 0; e < 32; ++e) acc[e] = 0.f;
        { int base = 0, pos[4] = {0, 0, 0, 0};
          const unsigned lmask = (1u << l5) - 1u;
#pragma unroll
          for (int bb = 0; bb < 16; ++bb) {
#pragma unroll
              for (int k = 0; k < 4; ++k) { const bool mine = (ev[k] >> 10) == bb; const unsigned long long m = __ballot(mine);
                  const unsigned mh = (unsigned)(half ? (m >> 32) : m);
                  if (mine) pos[k] = base + __popc(mh & lmask);
                  base += __popc(mh); } }
#pragma unroll
          for (int k = 0; k < 4; ++k) { LISTE[pos[k]] = ev[k]; LISTG[pos[k]] = gv[k]; } }
#pragma unroll 1
        for (int b = 0; b < 32; ++b) {
            const int lbase = b * 4;
            u32x6 ur[4], vr[4];
#pragma unroll
            for (int j = 0; j < 4; ++j) {
                const int e = LISTE[lbase + j];
                const unsigned* up = (const unsigned*)(UT8 + (size_t)e * 768 + 24 * l5); const u32x4 x = *(const u32x4*)up; const u32x2 y = *(const u32x2*)(up + 4);
                ur[j] = (u32x6){x.x, x.y, x.z, x.w, y.x, y.y};
                const unsigned* vp = (const unsigned*)(VT8 + (size_t)e * 768 + 24 * l5); const u32x4 x2 = *(const u32x4*)vp; const u32x2 y2 = *(const u32x2*)(vp + 4);
                vr[j] = (u32x6){x2.x, x2.y, x2.z, x2.w, y2.x, y2.y}; }
            const int kmine = (lane >> 3) & 3;
            const int emine = LISTE[lbase + kmine]; const float gmine = LISTG[lbase + kmine];
            const float su = SCU[emine], sv = SCV[emine];
            float p[4];
#pragma unroll
            for (int j = 0; j < 4; ++j) { const f32x32 uf = __builtin_amdgcn_cvt_scalef32_pk32_f32_fp6(ur[j], 1.0f); FP6_SETTLE(); float s = 0.f;
#pragma unroll
                for (int e = 0; e < 32; ++e) s = fmaf(uf[e], hf[e], s);
                p[j] = s; }
            float q2[2];
#pragma unroll
            for (int j = 0; j < 2; ++j) { const float snd = __uint_as_float(vsel(m16, __float_as_uint(p[j]), __float_as_uint(p[j + 2]))), kp = __uint_as_float(vsel(m16, __float_as_uint(p[j + 2]), __float_as_uint(p[j]))); q2[j] = kp + __shfl_xor(snd, 16); }
            float d;
            { const float snd = __uint_as_float(vsel(m8, __float_as_uint(q2[0]), __float_as_uint(q2[1]))), kp = __uint_as_float(vsel(m8, __float_as_uint(q2[1]), __float_as_uint(q2[0]))); d = kp + __shfl_xor(snd, 8); }
            d += __shfl_xor(d, 4); d += __shfl_xor(d, 2); d += __shfl_xor(d, 1);
            const float xx = d * su; const float wmine = 0.5f * xx * (1.f + erff(xx * 0.70710678118654752f)) * gmine * sv;
#pragma unroll
            for (int j = 0; j < 4; ++j) { const unsigned wa = __builtin_amdgcn_readlane(__float_as_uint(wmine), 8 * j), wb = __builtin_amdgcn_readlane(__float_as_uint(wmine), 32 + 8 * j);
                const float wgt = __uint_as_float(vsel(m32, wb, wa));
                const f32x32 vf = __builtin_amdgcn_cvt_scalef32_pk32_f32_fp6(vr[j], 1.0f); FP6_SETTLE();
#pragma unroll
                for (int e = 0; e < 32; ++e) acc[e] = fmaf(wgt, vf[e], acc[e]); }
        }
        { float* orow = out + (size_t)t * 1024 + 32 * l5;
#pragma unroll
            for (int q = 0; q < 8; ++q) { f32x4 x = *(const f32x4*)(orow + 4 * q); x += (f32x4){acc[4 * q], acc[4 * q + 1], acc[4 * q + 2], acc[4 * q + 3]}; *(f32x4*)(orow + 4 * q) = x; } }
    }
}

__device__ __forceinline__ Ctx mkctx(LAS unsigned char* lds, int wave0) {
    Ctx C; int w_ = wave0; asm volatile("" : "+s"(w_)); int tid = w_ * 64 + (int)__builtin_amdgcn_mbcnt_hi(~0u, __builtin_amdgcn_mbcnt_lo(~0u, 0u)); asm volatile("" : "+v"(tid));
    C.lds = lds; C.tid = tid; C.lane = tid & 63; C.wave = __builtin_amdgcn_readfirstlane(tid >> 6);
    C.G = gridDim.x; { const int bx = blockIdx.x; C.vcu = (C.G % 8 == 0) ? (bx % 8) * (C.G / 8) + bx / 8 : bx; }
    C.gw = C.vcu * NWAVES + C.wave; C.NGW = C.G * NWAVES; return C;
}
__device__ __forceinline__ unsigned long long ptr_from_lds(volatile LAS unsigned long long* PT, int i) {
    const unsigned long long v = PT[i];
    const unsigned lo = __builtin_amdgcn_readfirstlane((unsigned)v), hi = __builtin_amdgcn_readfirstlane((unsigned)(v >> 32));
    return ((unsigned long long)hi << 32) | lo;
}
#define DEF_PTRS \
    const Ctx C = mkctx(ldsb, wave0); const int lane = C.lane; (void)lane; \
    unsigned char* ws = WSP(); \
    const float* x = IN(I_X); \
    bf16_t* WinA = (bf16_t*)(ws + WS_WINA); bf16_t* WinB = (bf16_t*)(ws + WS_WINB); bf16_t* Wuq = (bf16_t*)(ws + WS_WUQ); bf16_t* Wukv = (bf16_t*)(ws + WS_WUKV); \
    bf16_t* Wda = (bf16_t*)(ws + WS_WDA); bf16_t* Wmla = (bf16_t*)(ws + WS_WMLA); bf16_t* Wout = (bf16_t*)(ws + WS_WOUT); bf16_t* Wq = (bf16_t*)(ws + WS_WQ); \
    bf16_t* KEYS = (bf16_t*)(ws + WS_KEYS); \
    bf16_t* XN = (bf16_t*)(ws + WS_A); bf16_t* YA = XN; bf16_t* H2 = XN; \
    bf16_t* OB = (bf16_t*)(ws + WS_B); \
    bf16_t* LAT = (bf16_t*)(ws + WS_LAT); bf16_t* QM = (bf16_t*)(ws + WS_QM); bf16_t* KN = (bf16_t*)(ws + WS_KN); bf16_t* VM = (bf16_t*)(ws + WS_VM); bf16_t* KRH = (bf16_t*)(ws + WS_KRH); \
    bf16_t* QA = (bf16_t*)(ws + WS_QA); bf16_t* KA = (bf16_t*)(ws + WS_KA); bf16_t* VA = (bf16_t*)(ws + WS_VA); bf16_t* OA = (bf16_t*)(ws + WS_OA); \
    bf16_t* MERGED = (bf16_t*)(ws + WS_MERGED); bf16_t* UT = (bf16_t*)(ws + WS_UT); bf16_t* VT = (bf16_t*)(ws + WS_VT); bf16_t* QP = (bf16_t*)(ws + WS_QP); \
    int* EIDX = (int*)(ws + WS_EIDX); float* GATE = (float*)(ws + WS_GATE); \
    unsigned char* UT8 = ws + WS_UT8; unsigned char* VT8 = ws + WS_VT8; float* SCU = (float*)(ws + WS_SCU); float* SCV = (float*)(ws + WS_SCV); float* SSQL = (float*)(ws + WS_SSQL); \
    bf16_t* GATES = (bf16_t*)OUTP(); \
    float* out = OUTP();
#ifndef PHMASK
#define PHMASK 0x1FFFF
#endif
#ifndef REPMASK
#define REPMASK 0
#endif
#ifndef REPTAIL
#define REPTAIL 1
#endif
__global__ void __launch_bounds__(NWAVES * 64, 2) mega_fwd(Args args) {
    extern __shared__ __attribute__((aligned(16))) unsigned char lds[];
    cg::grid_group grid = cg::this_grid();
    LAS unsigned char* const ldsb = (LAS unsigned char*)lds;
    const int wave0 = __builtin_amdgcn_readfirstlane((int)threadIdx.x >> 6);
    const Ctx C = mkctx(ldsb, wave0);
    unsigned* ctl = (unsigned*)args.ws;
    for (int u = C.tid; u < (LDS_BYTES - LDSCTL_OFF) / 4; u += NWAVES * 64) ((LAS unsigned*)(C.lds + LDSCTL_OFF))[u] = 0u;
    __syncthreads();
    if (__builtin_expect(args.ws == nullptr, 0)) grid.sync();
    XcdBarrier bar = xcd_barrier_post(ctl + CW_BAR, (volatile LAS unsigned*)(C.lds + MISC_OFF) + 8, C.tid);
#define GRID_BAR() do { const Ctx Cb = mkctx(ldsb, wave0); xcd_barrier(bar, Cb.tid); } while (0)

    volatile LAS unsigned long long* PT = (volatile LAS unsigned long long*)(C.lds + LDSCTL_OFF + 512);
    if (C.tid == 0) {
#define PTW(i) PT[i] = (unsigned long long)args.in[i];
        PTW(0) PTW(1) PTW(2) PTW(3) PTW(4) PTW(5) PTW(6) PTW(7) PTW(8) PTW(9) PTW(10) PTW(11) PTW(12) PTW(13) PTW(14) PTW(15) PTW(16) PTW(17) PTW(18) PTW(19) PTW(20) PTW(21) PTW(22) PTW(23) PTW(24)
#undef PTW
        PT[25] = (unsigned long long)args.out; PT[26] = (unsigned long long)args.ws;
    }
    __syncthreads();
#define PTR64(i) ptr_from_lds(PT, (i))
#define IN(i) ((const float*)(const GAS float*)PTR64(i))
#define OUTP() ((float*)(GAS float*)PTR64(25))
#define WSP() ((unsigned char*)(GAS unsigned char*)PTR64(26))

#pragma unroll 1
    for (int rep_ = 0; rep_ < (int)((REPMASK >> 0) & 1) + 1; ++rep_) {
#if (PHMASK >> 0) & 1
    { DEF_PTRS
    {
        LAS float* scr = (LAS float*)(C.lds + C.wave * 16384);
        int base = 0;
        const float* w_in = IN(I_WIN);
        tr_seg(C, scr, w_in, 1024, IN_COLS, 0, 3072, WinB, 0, base);
        tr_seg(C, scr, w_in, 1024, IN_COLS, 3776, 2048, WinA, 0, base);
        tr_seg(C, scr, w_in, 1024, IN_COLS, 3072, 384, WinA, 2048, base);
        tr_seg(C, scr, w_in, 1024, IN_COLS, 3456, 256, WinA, 2048 + 512, base);
        tr_seg(C, scr, w_in, 1024, IN_COLS, 3712, 64, WinA, 2048 + 768, base);
        tr_seg(C, scr, IN(I_MLA_WUQ), 384, 1536, 0, 1536, Wuq, 0, base, 0, 0, IN(I_MLA_QLN));
        for (int h = 0; h < 8; ++h) {
            tr_seg(C, scr, IN(I_MLA_WUKV), 256, 2048, h * 256, 128, Wukv, h * 128, base, 0, 0, IN(I_MLA_KVLN));
            tr_seg(C, scr, IN(I_MLA_WUKV), 256, 2048, h * 256 + 128, 128, Wukv, 1024 + h * 128, base, 0, 0, IN(I_MLA_KVLN));
        }
        tr_seg(C, scr, IN(I_DA_PROJ), 1024, 1024, 0, 1024, Wda, 0, base, 2048, 0);
        tr_seg(C, scr, IN(I_MLA_PROJ), 1024, 1024, 0, 1024, Wda, 0, base, 2048, 1024);
        tr_seg(C, scr, IN(I_WOUT), 1024, 1024, 0, 1024, Wout, 0, base);
        tr_seg(C, scr, IN(I_PEER_WQ), 1024, 2048, 0, 2048, Wq, 0, base);
        for (int i = C.gw * 64 + lane; i < (128 + 192) * 1024 / 8; i += C.NGW * 64) {
            const int r = i / 128, c8 = i % 128; const int row = r < 128 ? 2048 + 384 + r : 2048 + 832 + (r - 128);
            *(u32x4*)(WinA + (size_t)row * 1024 + c8 * 8) = (u32x4){0u, 0u, 0u, 0u}; }
        { const float* sk = IN(I_PEER_KEYS);
          for (int i = C.gw * 64 + lane; i < 262144 / 8; i += C.NGW * 64) { const f32x4 a = *(const f32x4*)(sk + (size_t)i * 8), b = *(const f32x4*)(sk + (size_t)i * 8 + 4);
              u32x4 w; w.x = cvt_pk_bf16(a.x, a.y); w.y = cvt_pk_bf16(a.z, a.w); w.z = cvt_pk_bf16(b.x, b.y); w.w = cvt_pk_bf16(b.z, b.w); *(u32x4*)(KEYS + (size_t)i * 8) = w; } }
        for (int m = C.gw; m < T; m += C.NGW) rms_row_f32_to_bf16(x + (size_t)m * 1024, IN(I_ATTN_NORM), XN + (size_t)m * 1024, lane);
    }
    }
#endif
    GRID_BAR();
    }

#pragma unroll 1
    for (int rep_ = 0; rep_ < (int)((REPMASK >> 1) & 1) + 1; ++rep_) {
#if (PHMASK >> 1) & 1
    { DEF_PTRS
    {
        pg8::Gemm g{XN, WinA, T, 3072, 1024, 1024, 1024}; pg8::StaticOrder S; S.init(T, 3072, C.G, (int)blockIdx.x);
        pg8::EpiStoreSS E{GATES, 2048, 2048, LAT, 1024, SSQL};
        pg8::gemm_phase<pg8::EpiStoreSS>(C.lds, g, S, E, C.tid);
    }
    }
#endif
    GRID_BAR();
    }
#pragma unroll 1
    for (int rep_ = 0; rep_ < (int)((REPMASK >> 3) & 1) + 1; ++rep_) {
#if (PHMASK >> 3) & 1
    { DEF_PTRS
    {
        pg8::Gemm g{LAT, Wuq, T, 1536, 384, 1024, 384}; pg8::StaticOrder S; S.init(T, 1536, C.G, (int)blockIdx.x);
        pg8::EpiRowScale E{QM, 1536, 0, 0, SSQL, 0, 8, 1.f / 384.f};
        pg8::gemm_phase<pg8::EpiRowScale>(C.lds, g, S, E, C.tid);
    }
    {
        pg8::Gemm g{LAT + 512, Wukv, T, 2048, 256, 1024, 256}; pg8::StaticOrder S; S.init(T, 2048, C.G, (int)blockIdx.x);
        pg8::EpiRowScale E{KN, 1024, 1024, (size_t)(WS_VM - WS_KN) / 2, SSQL, 8, 4, 1.f / 256.f};
        pg8::gemm_phase<pg8::EpiRowScale>(C.lds, g, S, E, C.tid);
    }
    }
#endif
    GRID_BAR();
    }
#pragma unroll 1
    for (int rep_ = 0; rep_ < (int)((REPMASK >> 4) & 1) + 1; ++rep_) {
#if (PHMASK >> 4) & 1
    { DEF_PTRS
    {
        const float* gq = IN(I_MLA_QN); const float* gk = IN(I_MLA_KN);
        const int hd = lane >> 3, j = lane & 7;
        for (int t = C.gw; t < T; t += C.NGW) {
            const float pos = (float)(t & (SEQ - 1));
            bf16_t* qrow = QM + (size_t)t * 1536 + hd * 192;
            const u32x4 a = *(const u32x4*)(qrow + 16 * j), b = *(const u32x4*)(qrow + 16 * j + 8), r = *(const u32x4*)(qrow + 128 + 8 * j);
            float v[16], rv[8]; unpack16(a, b, v); unpack8(r, rv);
            float pr[8];
#pragma unroll
            for (int e = 0; e < 8; ++e) pr[e] = __shfl_xor(rv[e], 4);
            float ro[8]; float snv[8], csv[8];
#pragma unroll
            for (int e = 0; e < 8; ++e) { const int i = (j & 3) * 8 + e; float sn, cs; sincosf(pos * rope_invf(i), &sn, &cs); snv[e] = sn; csv[e] = cs;
                ro[e] = (j < 4) ? (rv[e] * cs - pr[e] * sn) : (pr[e] * sn + rv[e] * cs); }
            float ss = 0.f;
#pragma unroll
            for (int e = 0; e < 16; ++e) ss += v[e] * v[e];
#pragma unroll
            for (int e = 0; e < 8; ++e) ss += ro[e] * ro[e];
            ss = grp_sum8(ss);
            const float rstd = QSCALE_MLA / sqrtf(ss * (1.f / 192.f) + EPS);
            float o[16], o2[8];
#pragma unroll
            for (int e = 0; e < 16; ++e) o[e] = v[e] * rstd * gq[16 * j + e];
#pragma unroll
            for (int e = 0; e < 8; ++e) o2[e] = ro[e] * rstd * gq[128 + 8 * j + e];
            *(u32x4*)(qrow + 16 * j) = pack8f(o); *(u32x4*)(qrow + 16 * j + 8) = pack8f(o + 8); *(u32x4*)(qrow + 128 + 8 * j) = pack8f(o2);
            bf16_t* krow = KN + (size_t)t * 1024 + hd * 128 + 16 * j;
            const u32x4 ka = *(const u32x4*)krow, kb = *(const u32x4*)(krow + 8), kr = *(const u32x4*)(LAT + (size_t)t * 1024 + 768 + 8 * j);
            float kv[16], krw[8], krv[8]; unpack16(ka, kb, kv); unpack8(kr, krw);
#pragma unroll
            for (int e = 0; e < 8; ++e) { const float kp = __shfl_xor(krw[e], 4); krv[e] = (j < 4) ? (krw[e] * csv[e] - kp * snv[e]) : (kp * snv[e] + krw[e] * csv[e]); }
            float ks = 0.f;
#pragma unroll
            for (int e = 0; e < 16; ++e) ks += kv[e] * kv[e];
#pragma unroll
            for (int e = 0; e < 8; ++e) ks += krv[e] * krv[e];
            ks = grp_sum8(ks);
            const float krstd = 1.f / sqrtf(ks * (1.f / 192.f) + EPS);
            float ko[16], ko2[8];
#pragma unroll
            for (int e = 0; e < 16; ++e) ko[e] = kv[e] * krstd * gk[16 * j + e];
#pragma unroll
            for (int e = 0; e < 8; ++e) ko2[e] = krv[e] * krstd * gk[128 + 8 * j + e];
            *(u32x4*)krow = pack8f(ko); *(u32x4*)(krow + 8) = pack8f(ko + 8);
            *(u32x4*)(KRH + (size_t)t * 512 + hd * 64 + 8 * j) = pack8f(ko2);
        }
    }
    }
#endif
    GRID_BAR();
    }
#pragma unroll 1
    for (int rep_ = 0; rep_ < (int)((REPMASK >> 5) & 1) + 1; ++rep_) {
#if (PHMASK >> 5) & 1
    { DEF_PTRS
    {
        char* alds = (char*)lds;
        const int head = C.vcu >> 4, xq = C.vcu & 15, b = head >> 3, h = head & 7;
        att::Seam S;
        auto mk = [&](int k) { const int qb = k == 0 ? 31 - xq : xq; att::BlockRef r;
            r.Q = QM + ((size_t)b * SEQ + (size_t)qb * 256) * 1536 + h * 192; r.K = KN + (size_t)b * SEQ * 1024 + h * 128; r.K2 = KRH + (size_t)b * SEQ * 512 + h * 64;
            r.V = VM + (size_t)b * SEQ * 1024 + h * 128; r.O = OB + ((size_t)b * SEQ + (size_t)qb * 256) * 1024 + h * 128; r.P0 = qb * 256; return r; };
        float negB;
        { const float* gq = IN(I_MLA_QN); const float* gk = IN(I_MLA_KN);
          float mq = fmaxf(fmaxf(fabsf(gq[lane]), fabsf(gq[lane + 64])), fabsf(gq[lane + 128])), mk_ = fmaxf(fmaxf(fabsf(gk[lane]), fabsf(gk[lane + 64])), fabsf(gk[lane + 128]));
#pragma unroll
          for (int o = 1; o < 64; o <<= 1) { mq = fmaxf(mq, __shfl_xor(mq, o)); mk_ = fmaxf(mk_, __shfl_xor(mk_, o)); }
          negB = -(192.f * mq * mk_ * QSCALE_MLA * 1.02f + 0.25f); }
        if (C.vcu < 256) {
            { const att::BlockRef cur = mk(0); att::attn_prime<192, 1536, 1024, 512, 1024>(cur, alds, S, C.tid); }
#pragma unroll 1
            for (int k = 0; k < 2; ++k) { int kk = k; asm volatile("" : "+s"(kk)); const att::BlockRef cur = mk(kk);
                att::attn_block<192, false, 1536, 1024, 512, 1024, 1024>(cur, 1, mk, alds, S, C.tid, negB); }
        }
    }
    }
#endif
    GRID_BAR();
    }
#pragma unroll 1
    for (int rep_ = 0; rep_ < (int)((REPMASK >> 6) & 1) + 1; ++rep_) {
#if (PHMASK >> 6) & 1
    { DEF_PTRS
    {
        pg8::Gemm g{XN, WinB, T, 3072, 1024, 1024, 1024}; pg8::StaticOrder S; S.init(T, 3072, C.G, (int)blockIdx.x);
        pg8::EpiNormQKV E{QA, (size_t)(WS_KA - WS_QA) / 2, IN(I_DA_QN), IN(I_DA_KN), QSCALE_DA, (LAS float*)(C.lds + 131072)};
        pg8::gemm_phase<pg8::EpiNormQKV>(C.lds, g, S, E, C.tid);
    }
    }
#endif
    GRID_BAR();
    }
#pragma unroll 1
    for (int rep_ = 0; rep_ < (int)((REPMASK >> 8) & 1) + 1; ++rep_) {
#if (PHMASK >> 8) & 1
    { DEF_PTRS
    {
        char* alds = (char*)lds;
        const int g8 = C.vcu >> 5, c = C.vcu & 31, b = g8 >> 2, h = g8 & 3;
        { float* bt = (float*)(alds + daw::OFF_BT); const float* rb = IN(I_RELB);
          const int i = C.tid; const int dist = i - 256; float val;
          if (dist < 0) val = -__builtin_inff();
          else { int bk; if (dist < 16) bk = dist; else { bk = 16; const int thr[15] = {19, 21, 24, 27, 31, 35, 40, 46, 52, 59, 67, 77, 87, 99, 113};
#pragma unroll
                  for (int q = 0; q < 15; ++q) bk += (dist >= thr[q]) ? 1 : 0; }
              val = (rb[bk * 4 + h] - rb[31 * 4 + h]) * LOG2E; }
          bt[i] = val; }
        auto mk = [&](int k) { const int m = c >> 4, xq = c & 15; const int qb = (k & 1) ? xq : 31 - xq;
            daw::BlockRef r;
            r.Q = QA + ((size_t)b * SEQ + (size_t)qb * 256) * 1024 + (h * 2 + m) * 128; r.K = KA + (size_t)b * SEQ * 1024 + (h * 2 + m) * 128;
            r.V = VA + (size_t)b * SEQ * 1024 + h * 256; r.O = OA + ((size_t)b * SEQ + (size_t)qb * 256) * 2048 + h * 512 + m * 256; r.P0 = qb * 256; return r; };
        float negB;
        { const float* gq = IN(I_DA_QN); const float* gk = IN(I_DA_KN); const float* rb = IN(I_RELB);
          float mq = fmaxf(fabsf(gq[lane]), fabsf(gq[lane + 64])), mk_ = fmaxf(fabsf(gk[lane]), fabsf(gk[lane + 64]));
          float mb = (rb[(lane & 31) * 4 + h] - rb[31 * 4 + h]) * LOG2E;
#pragma unroll
          for (int o = 1; o < 64; o <<= 1) { mq = fmaxf(mq, __shfl_xor(mq, o)); mk_ = fmaxf(mk_, __shfl_xor(mk_, o)); mb = fmaxf(mb, __shfl_xor(mb, o)); }
          negB = -(128.f * mq * mk_ * QSCALE_DA * 1.02f + 0.25f + fmaxf(mb, 0.f)); }
        if (C.vcu < 256) {
            { const daw::BlockRef cur = mk(0); daw::prime<1024, 1024, 1024>(cur, alds, C.tid); }
#pragma unroll 1
            for (int k = 0; k < 2; ++k) { int kk = k; asm volatile("" : "+s"(kk)); const daw::BlockRef cur = mk(kk);
                daw::block<1024, 1024, 1024, 2048>(cur, 1, mk, alds, C.tid, negB); }
        }
    }
    }
#endif
    GRID_BAR();
    }
#pragma unroll 1
    for (int rep_ = 0; rep_ < (int)((REPMASK >> 9) & 1) + 1; ++rep_) {
#if (PHMASK >> 9) & 1
    { DEF_PTRS
    {
        float lam;
        { const float q1 = IN(I_LQ1)[lane] * IN(I_LK1)[lane] + IN(I_LQ1)[lane + 64] * IN(I_LK1)[lane + 64];
          const float q2 = IN(I_LQ2)[lane] * IN(I_LK2)[lane] + IN(I_LQ2)[lane + 64] * IN(I_LK2)[lane + 64];
          lam = expf(wave_sum(q1)) - expf(wave_sum(q2)) + 0.2f; }
        const float* gn = IN(I_DA_ON);
        const int hd = lane >> 4, jj = lane & 15;
        for (int t = C.gw; t < T; t += C.NGW) {
            const bf16_t* r0 = OA + (size_t)t * 2048 + hd * 512 + 16 * jj;
            const u32x4 a0 = *(const u32x4*)r0, b0 = *(const u32x4*)(r0 + 8), a1 = *(const u32x4*)(r0 + 256), b1 = *(const u32x4*)(r0 + 264);
            float v0[16], v1[16]; unpack16(a0, b0, v0); unpack16(a1, b1, v1);
            float y[16]; float ss = 0.f;
#pragma unroll
            for (int e = 0; e < 16; ++e) { y[e] = v0[e] - lam * v1[e]; ss += y[e] * y[e]; }
            ss = grp_sum16(ss);
            const float rstd = 0.8f / sqrtf(ss * (1.f / 256.f) + EPS);
#pragma unroll
            for (int e = 0; e < 16; ++e) y[e] = y[e] * rstd * gn[16 * jj + e];
            bf16_t* orow = YA + (size_t)t * 1024 + hd * 256 + 16 * jj;
            *(u32x4*)orow = pack8f(y); *(u32x4*)(orow + 8) = pack8f(y + 8);
        }
        const float* pu = IN(I_PEER_U); const float* pv = IN(I_PEER_V);
        for (int r2 = C.gw; r2 < 16384; r2 += C.NGW) {
            const int r = r2 * 2 + (lane >> 5), tb = r >> 14, e = r & 16383, l5 = lane & 31;
            const float* src_ = (tb ? pv : pu) + (size_t)e * 1024 + 32 * l5;
            f32x16 xa, xb; float am = 0.f;
#pragma unroll
            for (int q = 0; q < 4; ++q) { const f32x4 a = *(const f32x4*)(src_ + 4 * q), b = *(const f32x4*)(src_ + 16 + 4 * q);
                xa[2 * q] = a.x; xb[2 * q] = a.y; xa[2 * q + 1] = a.z; xb[2 * q + 1] = a.w; xa[8 + 2 * q] = b.x; xb[8 + 2 * q] = b.y; xa[8 + 2 * q + 1] = b.z; xb[8 + 2 * q + 1] = b.w;
                am = fmaxf(am, fmaxf(fmaxf(fmaxf(fabsf(a.x), fabsf(a.y)), fmaxf(fabsf(a.z), fabsf(a.w))), fmaxf(fmaxf(fabsf(b.x), fabsf(b.y)), fmaxf(fabsf(b.z), fabsf(b.w))))); }
#pragma unroll
            for (int o = 1; o < 32; o <<= 1) am = fmaxf(am, __shfl_xor(am, o));
            const float sc = am > 0.f ? 7.5f / am : 0.f;
            const u32x6 w = __builtin_amdgcn_cvt_scalef32_2xpk16_fp6_f32(xa * sc, xb * sc, 1.0f); FP6_SETTLE();
            unsigned* dst = (unsigned*)((tb ? VT8 : UT8) + (size_t)e * 768 + 24 * l5);
            *(u32x2*)dst = (u32x2){w[0], w[1]}; *(u32x2*)(dst + 2) = (u32x2){w[2], w[3]}; *(u32x2*)(dst + 4) = (u32x2){w[4], w[5]};
            if (l5 == 0) (tb ? SCV : SCU)[e] = am * (1.f / 7.5f);
        }
    }
    }
#endif
    GRID_BAR();
    }
#pragma unroll 1
    for (int rep_ = 0; rep_ < (int)((REPMASK >> 10) & 1) + 1; ++rep_) {
#if (PHMASK >> 10) & 1
    { DEF_PTRS
    {
        pg8::Gemm g{YA, Wda, T, 1024, 2048, 1024, 2048, OB, 1024}; pg8::StaticOrder S; S.init(T, 1024, C.G, (int)blockIdx.x);
        pg8::EpiGate2 E{GATES, 2048, MERGED, 1024};
        pg8::gemm_phase<pg8::EpiGate2, true>(C.lds, g, S, E, C.tid);
    }
    }
#endif
    GRID_BAR();
    }
#pragma unroll 1
    for (int rt_ = 0; rt_ < REPTAIL; ++rt_) {
#pragma unroll 1
    for (int rep_ = 0; rep_ < (int)((REPMASK >> 12) & 1) + 1; ++rep_) {
#if (PHMASK >> 12) & 1
    { DEF_PTRS
    {
        pg8::Gemm g{MERGED, Wout, T, 1024, 1024, 1024, 1024}; pg8::StaticOrder S; S.init(T, 1024, C.G, (int)blockIdx.x);
        pg8::EpiResid E{x, out, 1024};
        pg8::gemm_phase<pg8::EpiResid>(C.lds, g, S, E, C.tid);
    }
    }
#endif
    GRID_BAR();
    }
#pragma unroll 1
    for (int rep_ = 0; rep_ < (int)((REPMASK >> 13) & 1) + 1; ++rep_) {
#if (PHMASK >> 13) & 1
    { DEF_PTRS
    for (int m = C.gw; m < T; m += C.NGW) rms_row_f32_to_bf16(out + (size_t)m * 1024, IN(I_FFN_NORM), H2 + (size_t)m * 1024, lane);
    }
#endif
    GRID_BAR();
    }
#pragma unroll 1
    for (int rep_ = 0; rep_ < (int)((REPMASK >> 14) & 1) + 1; ++rep_) {
#if (PHMASK >> 14) & 1
    { DEF_PTRS
    {
        pg8::Gemm g{H2, Wq, T, 2048, 1024, 1024, 1024}; pg8::StaticOrder S; S.init(T, 2048, C.G, (int)blockIdx.x);
        pg8::EpiStore E{QP, 2048, 0, 0, 0, nullptr, 0};
        pg8::gemm_phase<pg8::EpiStore>(C.lds, g, S, E, C.tid);
    }
    }
#endif
    GRID_BAR();
    }
#pragma unroll 1
    for (int rep_ = 0; rep_ < (int)((REPMASK >> 15) & 1) + 1; ++rep_) {
#if (PHMASK >> 15) & 1
    { DEF_PTRS
    p7_topk(C, QP, KEYS, EIDX, GATE);
    }
#endif
    GRID_BAR();
    }
#pragma unroll 1
    for (int rep_ = 0; rep_ < (int)((REPMASK >> 16) & 1) + 1; ++rep_) {
#if (PHMASK >> 16) & 1
    { DEF_PTRS
    p8_gather(C, H2, UT8, VT8, SCU, SCV, EIDX, GATE, out);
    }
#endif
    }
    if (rt_ + 1 < REPTAIL) GRID_BAR();
    }
}

extern "C" void kernel_launch(void* const* d_in, const int* in_sizes, int n_in, void* d_out, int out_size, void* d_ws, size_t ws_size, hipStream_t stream) {
    static int grid = 0;
    if (grid == 0) {
        int dev = 0, cus = 0, per_cu = 0;
        (void)hipGetDevice(&dev);
        (void)hipDeviceGetAttribute(&cus, hipDeviceAttributeMultiprocessorCount, dev);
        (void)hipFuncSetAttribute((const void*)mega_fwd, hipFuncAttributeMaxDynamicSharedMemorySize, LDS_BYTES);
        (void)hipOccupancyMaxActiveBlocksPerMultiprocessor(&per_cu, (const void*)mega_fwd, NWAVES * 64, LDS_BYTES);
        if (per_cu < 1) { fprintf(stderr, "kernel_launch: occupancy query says %d\n", per_cu); }
        grid = 256;
        if (cus * per_cu < grid) fprintf(stderr, "kernel_launch: device holds only %d x %d resident workgroups; 256 needed\n", cus, per_cu);
        if (n_in != 25 || out_size != T * D || ws_size < WS_END) fprintf(stderr, "kernel_launch: unexpected n_in %d out %d ws %zu\n", n_in, out_size, ws_size);
    }
    (void)hipMemsetAsync(d_ws, 0, CTL_ZERO_BYTES, stream);
    Args a{};
    for (int i = 0; i < 25 && i < n_in; ++i) a.in[i] = (const float*)d_in[i];
    a.out = (float*)d_out; a.ws = (unsigned char*)d_ws;
    void* kargs[] = {&a};
    hipError_t e = hipLaunchCooperativeKernel((const void*)mega_fwd, dim3(grid), dim3(NWAVES * 64), kargs, LDS_BYTES, stream);
    if (e != hipSuccess) fprintf(stderr, "cooperative launch failed: %s (grid %d)\n", hipGetErrorString(e), grid);
}
```

```cpp
#include <hip/hip_runtime.h>
#include <hip/hip_cooperative_groups.h>
#include <hip/hip_bf16.h>
#include <cstdio>
#include <cstdint>
#include <cmath>
namespace cg = cooperative_groups;

#define LAS __attribute__((address_space(3)))
#define GAS __attribute__((address_space(1)))
typedef unsigned short bf16_t;
typedef short bf16x8 __attribute__((ext_vector_type(8)));
typedef short s16x4 __attribute__((ext_vector_type(4)));
typedef float f32x4 __attribute__((ext_vector_type(4)));
typedef float f32x2 __attribute__((ext_vector_type(2)));
typedef float f32x16 __attribute__((ext_vector_type(16)));
typedef unsigned u32x4 __attribute__((ext_vector_type(4)));
typedef unsigned u32x2 __attribute__((ext_vector_type(2)));
typedef unsigned u32x6 __attribute__((ext_vector_type(6)));
typedef float f32x32 __attribute__((ext_vector_type(32)));
typedef __bf16 bf16x32v __attribute__((ext_vector_type(32)));
typedef __bf16 bf16x2v __attribute__((ext_vector_type(2)));

constexpr int NWAVES = 8;
constexpr int BATCH = 2, SEQ = 8192, T = BATCH * SEQ, D = 1024;
constexpr int IN_COLS = 5824;
constexpr float EPS = 1e-6f;
constexpr float LOG2E = 1.4426950408889634f;
constexpr float QSCALE_DA = 0.08838834764831845f * LOG2E;
constexpr float QSCALE_MLA = 0.07216878364870323f * LOG2E;

constexpr size_t MiB = 1u << 20;
constexpr size_t CTL_ZERO_BYTES = 32 * 1024;
constexpr size_t WS_WINA = 1 * MiB, WS_WINB = 7 * MiB, WS_WUQ = 13 * MiB, WS_WUKV = 14 * MiB + 256 * 1024, WS_WDA = 15 * MiB + 256 * 1024,
                 WS_WMLA = 17 * MiB + 256 * 1024, WS_WOUT = 19 * MiB + 256 * 1024, WS_WQ = 21 * MiB + 256 * 1024, WS_KEYS = 25 * MiB + 256 * 1024;
constexpr size_t WS_A = 26 * MiB;
constexpr size_t WS_B = 58 * MiB;
constexpr size_t WS_C = 90 * MiB;
constexpr size_t WS_LAT = WS_C, WS_QM = WS_C + 32 * MiB, WS_KN = WS_C + 80 * MiB, WS_VM = WS_C + 112 * MiB, WS_KRH = WS_C + 144 * MiB;
constexpr size_t WS_QA = WS_C, WS_KA = WS_C + 32 * MiB, WS_VA = WS_C + 64 * MiB, WS_OA = WS_C + 96 * MiB;
constexpr size_t WS_MERGED = WS_C, WS_UT = WS_C + 32 * MiB, WS_VT = WS_C + 64 * MiB, WS_QP = WS_C + 96 * MiB;
constexpr size_t WS_EIDX = WS_B, WS_GATE = WS_B + 8 * MiB;
constexpr size_t WS_UT8 = WS_UT, WS_VT8 = WS_UT + 16 * MiB, WS_SCU = WS_UT + 32 * MiB, WS_SCV = WS_SCU + 64 * 1024, WS_SCP = WS_SCU + 128 * 1024;
constexpr size_t WS_SSQL = WS_B;
constexpr size_t WS_END = 256 * MiB;
static_assert(WS_KRH + 16 * MiB <= WS_END && WS_OA + 64 * MiB <= WS_END && WS_QP + 64 * MiB <= WS_END, "ws map");
constexpr int CW_BAR = 4096;

constexpr int RING_BYTES = 155648, LDSCTL_OFF = RING_BYTES, MISC_OFF = LDSCTL_OFF + 320;
constexpr int LDS_BYTES = 160 * 1024;

#define FP6_SETTLE() do { __builtin_amdgcn_sched_barrier(0); asm volatile("s_nop 15\n\ts_nop 3"); __builtin_amdgcn_sched_barrier(0); } while (0)
__device__ __forceinline__ unsigned cvt_pk_bf16(float lo, float hi) { unsigned r; asm volatile("v_cvt_pk_bf16_f32 %0, %1, %2" : "=v"(r) : "v"(lo), "v"(hi)); return r; }
__device__ __forceinline__ float bf_lo(unsigned u) { return __uint_as_float(u << 16); }
__device__ __forceinline__ float bf_hi(unsigned u) { return __uint_as_float(u & 0xffff0000u); }
__device__ __forceinline__ float wave_sum(float v) {
#pragma unroll
    for (int o = 1; o < 64; o <<= 1) v += __shfl_xor(v, o);
    return v;
}
__device__ __forceinline__ float grp_sum8(float v) { v += __shfl_xor(v, 1); v += __shfl_xor(v, 2); v += __shfl_xor(v, 4); return v; }
__device__ __forceinline__ float grp_sum16(float v) { v = grp_sum8(v); v += __shfl_xor(v, 8); return v; }
__device__ __forceinline__ void unpack16(const u32x4& a, const u32x4& b, float (&v)[16]) {
    v[0] = bf_lo(a.x); v[1] = bf_hi(a.x); v[2] = bf_lo(a.y); v[3] = bf_hi(a.y); v[4] = bf_lo(a.z); v[5] = bf_hi(a.z); v[6] = bf_lo(a.w); v[7] = bf_hi(a.w);
    v[8] = bf_lo(b.x); v[9] = bf_hi(b.x); v[10] = bf_lo(b.y); v[11] = bf_hi(b.y); v[12] = bf_lo(b.z); v[13] = bf_hi(b.z); v[14] = bf_lo(b.w); v[15] = bf_hi(b.w);
}
__device__ __forceinline__ void unpack8(const u32x4& a, float (&v)[8]) {
    v[0] = bf_lo(a.x); v[1] = bf_hi(a.x); v[2] = bf_lo(a.y); v[3] = bf_hi(a.y); v[4] = bf_lo(a.z); v[5] = bf_hi(a.z); v[6] = bf_lo(a.w); v[7] = bf_hi(a.w);
}
__device__ __forceinline__ u32x4 pack8f(const float* v) { u32x4 w; w.x = cvt_pk_bf16(v[0], v[1]); w.y = cvt_pk_bf16(v[2], v[3]); w.z = cvt_pk_bf16(v[4], v[5]); w.w = cvt_pk_bf16(v[6], v[7]); return w; }

#define XB_TMO      128
#define XB_XCNT(j)  (256  + 64 * (j))
#define XB_XSUB(j)  (1280 + 64 * (j))
#define XB_XGEN(j)  (2304 + 64 * (j))
#define XB_TOP      3328
#define XB_TOPGEN   3392
#define XCD_BAR_WORDS 3456
#define XB_SPIN_CAP (1u << 18)
__device__ __forceinline__ unsigned xb_ld(unsigned* p)              { return __hip_atomic_load(p, __ATOMIC_RELAXED, __HIP_MEMORY_SCOPE_AGENT); }
__device__ __forceinline__ unsigned xb_add(unsigned* p, unsigned v) { return __hip_atomic_fetch_add(p, v, __ATOMIC_RELAXED, __HIP_MEMORY_SCOPE_AGENT); }
__device__ __forceinline__ unsigned xb_xcc_id() { return (unsigned)__builtin_amdgcn_s_getreg((3 << 11) | 20) & 0xFu; }
#define XB_SPIN(cond, bar) do { unsigned _sp = 0; while (cond) { __builtin_amdgcn_s_sleep(1); \
    if ((++_sp & 255u) == 0u) { if (xb_ld(&(bar)[XB_TMO])) break; if (_sp > XB_SPIN_CAP) { atomicAdd(&(bar)[XB_TMO], 1u); break; } } } } while (0)
struct XcdBarrier { unsigned* bar; unsigned x; volatile LAS unsigned* st; };
__device__ __forceinline__ XcdBarrier xcd_barrier_post(unsigned* bar, volatile LAS unsigned* st, int tid) {
    XcdBarrier b; b.bar = bar; b.x = xb_xcc_id(); b.st = st;
    if (tid == 0) (void)xb_add(&bar[XB_XCNT(b.x)], 1u);
    return b;
}
__device__ __forceinline__ void xcd_barrier_complete(unsigned* bar, unsigned x, unsigned& nloc, unsigned& nx) {
    const unsigned G = gridDim.x * gridDim.y * gridDim.z;
    unsigned sum, cnt, mine, sp = 0u;
    for (;;) {
        sum = 0u; cnt = 0u; mine = 0u;
#pragma unroll
        for (unsigned j = 0; j < 16; ++j) { const unsigned c = xb_ld(&bar[XB_XCNT(j)]); sum += c; cnt += (c > 0u) ? 1u : 0u; mine = (j == x) ? c : mine; }
        if (sum == G) break;
        __builtin_amdgcn_s_sleep(1);
        if ((++sp & 255u) == 0u) { if (xb_ld(&bar[XB_TMO])) break; if (sp > XB_SPIN_CAP) { atomicAdd(&bar[XB_TMO], 1u); break; } }
    }
    nloc = mine > 0u ? mine : 1u; nx = cnt > 0u ? cnt : 1u;
}
__device__ __forceinline__ void xcd_barrier(const XcdBarrier& b, int tid) {
    asm volatile("s_waitcnt vmcnt(0)" ::: "memory");
    __syncthreads();
    if (tid == 0) {
        unsigned* bar = b.bar;
        __builtin_amdgcn_s_waitcnt(0);
        unsigned nloc = b.st[0], nx = b.st[1];
        if (nloc == 0u) { xcd_barrier_complete(bar, b.x, nloc, nx); b.st[0] = nloc; b.st[1] = nx; }
        const unsigned old = xb_add(&bar[XB_XSUB(b.x)], 1u);
        const unsigned gen = old / nloc;
        if (old + 1u == (gen + 1u) * nloc) {
            __builtin_amdgcn_fence(__ATOMIC_RELEASE, "agent");
            asm volatile("s_waitcnt vmcnt(0)" ::: "memory");
            const unsigned og = xb_add(&bar[XB_TOP], 1u);
            const unsigned tg = og / nx;
            if (og + 1u == (tg + 1u) * nx) xb_add(&bar[XB_TOPGEN], 1u);
            else XB_SPIN(xb_ld(&bar[XB_TOPGEN]) == tg, bar);
            __builtin_amdgcn_fence(__ATOMIC_ACQUIRE, "agent");
            xb_add(&bar[XB_XGEN(b.x)], 1u);
            asm volatile("s_waitcnt vmcnt(0)" ::: "memory");
        } else {
            XB_SPIN(xb_ld(&bar[XB_XGEN(b.x)]) == gen, bar);
            __builtin_amdgcn_fence(__ATOMIC_ACQUIRE, "agent");
            asm volatile("s_waitcnt vmcnt(0)" ::: "memory");
        }
    }
    __syncthreads();
}

namespace pg8 {
constexpr int BM = 256, BK = 64, HALF = 128, HTB = HALF * BK * 2, STAGE_BYTES = 8 * HTB, NXCD = 8, WGM = 4;
__host__ __device__ __forceinline__ int lds_byte(int r, int c) { const int st = (r >> 4) * 2 + (c >> 5), rr = r & 15, cc = c & 31, ob = rr * 64 + cc * 2; return st * 1024 + (ob ^ (((ob >> 9) & 1) << 5)); }
__host__ __device__ __forceinline__ void stage_rc(int b, int& R, int& C) { const int st = b / 1024, sb = b % 1024, swz = sb ^ (((sb >> 9) & 1) << 5); R = (st >> 1) * 16 + swz / 64; C = (st & 1) * 32 + (swz % 64) / 2; }
__host__ __device__ __forceinline__ int perm32(int rho) { const int n = rho >> 4, i = rho & 15; return 8 * (i >> 2) + 4 * n + (i & 3); }
struct Unit { int pm, pn; };
struct Gemm { const bf16_t* A; const bf16_t* Bt; int M, N, K, lda, ldb; const bf16_t* A2 = nullptr; int K1 = 0; };
struct StaticOrder {
    int nM, nN, nwg, G, c;
    __device__ void init(int M, int N, int G_, int c_) { nM = M / BM; nN = N / BM; nwg = nM * nN; G = G_; c = c_; }
    __device__ bool next(int i, Unit& u) const {
        const long L = (long)i * G + c; if (L >= nwg) return false;
        int wgid = (int)L; { const int q = nwg / NXCD, r = nwg % NXCD, xcd = wgid % NXCD, off = wgid / NXCD; wgid = (xcd < r ? xcd * (q + 1) : r * (q + 1) + (xcd - r) * q) + off; }
        const int nig = WGM * nN, gid = wgid / nig, fm = gid * WGM, gsz = (nM - fm) < WGM ? (nM - fm) : WGM;
        u.pm = fm + ((wgid % nig) % gsz); u.pn = (wgid % nig) / gsz; return true;
    }
};
struct EpiStore {
    bf16_t* O; int ldc; int split_cols; size_t split_stride; int cut; bf16_t* O2; int ldc2;
    __device__ __forceinline__ void operator()(const f32x4 (&acc)[2][2][4][2], const Unit& u, int wr, int wc, int fr, int fq) const {
        const int row0 = u.pm * BM + wr * 64 + fr; int colt = u.pn * BM; bf16_t* base = O; int ld = ldc;
        if (cut && colt >= cut) { base = O2; ld = ldc2; colt -= cut; }
        else if (split_cols) { const int t = colt / split_cols; base += (size_t)t * split_stride; colt -= t * split_cols; }
        const int col0 = colt + wc * 32 + 8 * fq;
#pragma unroll
        for (int ai = 0; ai < 2; ++ai)
#pragma unroll
            for (int m = 0; m < 4; ++m) { bf16_t* rowp = base + (size_t)(row0 + ai * HALF + m * 16) * ld + col0;
#pragma unroll
                for (int bj = 0; bj < 2; ++bj) { const f32x4 v0 = acc[ai][bj][m][0], v1 = acc[ai][bj][m][1];
                    u32x4 w; w.x = cvt_pk_bf16(v0[0], v0[1]); w.y = cvt_pk_bf16(v0[2], v0[3]); w.z = cvt_pk_bf16(v1[0], v1[1]); w.w = cvt_pk_bf16(v1[2], v1[3]);
                    *(u32x4*)(rowp + bj * HALF) = w; } }
    }
};
struct EpiStoreSS {
    bf16_t* O; int ldc; int cut; bf16_t* O2; int ldc2; float* SS;
    __device__ __forceinline__ void operator()(const f32x4 (&acc)[2][2][4][2], const Unit& u, int wr, int wc, int fr, int fq) const {
        int fr_ = fr, fq_ = fq; asm volatile("" : "+v"(fr_), "+v"(fq_));
        const int row0 = u.pm * BM + wr * 64 + fr_; int colt = u.pn * BM; bf16_t* base = O; int ld = ldc; const bool lat = colt >= cut;
        if (lat) { base = O2; ld = ldc2; colt -= cut; }
        const int col0 = colt + wc * 32 + 8 * fq_;
#pragma unroll
        for (int ai = 0; ai < 2; ++ai)
#pragma unroll
            for (int m = 0; m < 4; ++m) { const int row = row0 + ai * HALF + m * 16; bf16_t* rowp = base + (size_t)row * ld + col0; float ss = 0.f;
#pragma unroll
                for (int bj = 0; bj < 2; ++bj) { const f32x4 v0 = acc[ai][bj][m][0], v1 = acc[ai][bj][m][1];
                    u32x4 w; w.x = cvt_pk_bf16(v0[0], v0[1]); w.y = cvt_pk_bf16(v0[2], v0[3]); w.z = cvt_pk_bf16(v1[0], v1[1]); w.w = cvt_pk_bf16(v1[2], v1[3]);
                    *(u32x4*)(rowp + bj * HALF) = w;
                    ss += (v0[0] * v0[0] + v0[1] * v0[1]) + (v0[2] * v0[2] + v0[3] * v0[3]) + (v1[0] * v1[0] + v1[1] * v1[1]) + (v1[2] * v1[2] + v1[3] * v1[3]); }
                if (lat) { ss += __shfl_xor(ss, 16); ss += __shfl_xor(ss, 32);
                           if (fq_ == 0) SS[(size_t)row * 16 + (colt >> 8) * 4 + wc] = ss; } }
    }
};
struct EpiRowScale {
    bf16_t* O; int ldc; int split_cols; size_t split_stride; const float* SS; int s0, ns; float inv_dim;
    __device__ __forceinline__ void operator()(const f32x4 (&acc)[2][2][4][2], const Unit& u, int wr, int wc, int fr, int fq) const {
        int fr_ = fr, fq_ = fq; asm volatile("" : "+v"(fr_), "+v"(fq_));
        const int row0 = u.pm * BM + wr * 64 + fr_; int colt = u.pn * BM; bf16_t* base = O;
        if (split_cols) { const int t = colt / split_cols; base += (size_t)t * split_stride; colt -= t * split_cols; }
        const int col0 = colt + wc * 32 + 8 * fq_;
#pragma unroll
        for (int ai = 0; ai < 2; ++ai)
#pragma unroll
            for (int m = 0; m < 4; ++m) { const int row = row0 + ai * HALF + m * 16;
                const f32x4* sp = (const f32x4*)(SS + (size_t)row * 16 + s0); f32x4 sv = sp[0]; if (ns > 4) sv += sp[1];
                const float rstd = 1.f / sqrtf(((sv[0] + sv[1]) + (sv[2] + sv[3])) * inv_dim + EPS);
                bf16_t* rowp = base + (size_t)row * ldc + col0;
#pragma unroll
                for (int bj = 0; bj < 2; ++bj) { const f32x4 v0 = acc[ai][bj][m][0] * rstd, v1 = acc[ai][bj][m][1] * rstd;
                    u32x4 w; w.x = cvt_pk_bf16(v0[0], v0[1]); w.y = cvt_pk_bf16(v0[2], v0[3]); w.z = cvt_pk_bf16(v1[0], v1[1]); w.w = cvt_pk_bf16(v1[2], v1[3]);
                    *(u32x4*)(rowp + bj * HALF) = w; } }
    }
};
template <bool ACCUM> struct EpiGate {
    const bf16_t* Gt; int ldg; bf16_t* Tio; int ldc;
    __device__ __forceinline__ void operator()(const f32x4 (&acc)[2][2][4][2], const Unit& u, int wr, int wc, int fr, int fq) const {
        const int row0 = u.pm * BM + wr * 64 + fr; const int col0 = u.pn * BM + wc * 32 + 8 * fq;
#pragma unroll
        for (int ai = 0; ai < 2; ++ai)
#pragma unroll
            for (int m = 0; m < 4; ++m) { const size_t r = (size_t)(row0 + ai * HALF + m * 16);
#pragma unroll
                for (int bj = 0; bj < 2; ++bj) { const f32x4 v0 = acc[ai][bj][m][0], v1 = acc[ai][bj][m][1];
                    const u32x4 gw = *(const u32x4*)(Gt + r * ldg + col0 + bj * HALF);
                    float g[8]; unpack8(gw, g); float o[8];
#pragma unroll
                    for (int e = 0; e < 8; ++e) { const float a = e < 4 ? v0[e] : v1[e - 4]; const float s = __builtin_amdgcn_rcpf(1.f + __builtin_amdgcn_exp2f(-g[e] * LOG2E)); o[e] = s * a; }
                    bf16_t* p = Tio + r * ldc + col0 + bj * HALF;
                    if (ACCUM) { const u32x4 tw = *(const u32x4*)p; float t[8]; unpack8(tw, t);
#pragma unroll
                        for (int e = 0; e < 8; ++e) o[e] += t[e]; }
                    *(u32x4*)p = pack8f(o); } }
    }
};
struct EpiGate2 {
    const bf16_t* Gt; int ldg; bf16_t* To; int ldc;
    static __device__ __forceinline__ float em(float g) { return __builtin_amdgcn_exp2f(-fminf(fmaxf(g, -30.f), 30.f) * LOG2E); }
    __device__ __forceinline__ void mid(f32x4 (&acc)[2][2][4][2], const Unit& u, int wr, int wc, int fr, int fq) const {
        int fr_ = fr, fq_ = fq; asm volatile("" : "+v"(fr_), "+v"(fq_));
        const int row0 = u.pm * BM + wr * 64 + fr_; const int col0 = u.pn * BM + wc * 32 + 8 * fq_;
#pragma unroll
        for (int ai = 0; ai < 2; ++ai)
#pragma unroll
            for (int m = 0; m < 4; ++m) { const size_t r = (size_t)(row0 + ai * HALF + m * 16);
#pragma unroll
                for (int bj = 0; bj < 2; ++bj) {
                    const u32x4 gw0 = *(const u32x4*)(Gt + r * ldg + col0 + bj * HALF), gw1 = *(const u32x4*)(Gt + r * ldg + 1024 + col0 + bj * HALF);
                    float g0[8], g1[8]; unpack8(gw0, g0); unpack8(gw1, g1);
#pragma unroll
                    for (int e = 0; e < 8; ++e) { const float rt = (1.f + em(g1[e])) * __builtin_amdgcn_rcpf(1.f + em(g0[e]));
                        if (e < 4) acc[ai][bj][m][0][e] *= rt; else acc[ai][bj][m][1][e - 4] *= rt; } }
                asm volatile("" ::: "memory"); }
    }
    __device__ __forceinline__ void operator()(const f32x4 (&acc)[2][2][4][2], const Unit& u, int wr, int wc, int fr, int fq) const {
        int fr_ = fr, fq_ = fq; asm volatile("" : "+v"(fr_), "+v"(fq_));
        const int row0 = u.pm * BM + wr * 64 + fr_; const int col0 = u.pn * BM + wc * 32 + 8 * fq_;
#pragma unroll
        for (int ai = 0; ai < 2; ++ai)
#pragma unroll
            for (int m = 0; m < 4; ++m) { const size_t r = (size_t)(row0 + ai * HALF + m * 16);
#pragma unroll
                for (int bj = 0; bj < 2; ++bj) { const f32x4 v0 = acc[ai][bj][m][0], v1 = acc[ai][bj][m][1];
                    const u32x4 gw = *(const u32x4*)(Gt + r * ldg + 1024 + col0 + bj * HALF);
                    float g[8]; unpack8(gw, g); float o[8];
#pragma unroll
                    for (int e = 0; e < 8; ++e) { const float a = e < 4 ? v0[e] : v1[e - 4]; o[e] = a * __builtin_amdgcn_rcpf(1.f + em(g[e])); }
                    *(u32x4*)(To + r * ldc + col0 + bj * HALF) = pack8f(o); } }
    }
};
struct EpiResid {
    const float* X; float* O; int ldc;
    __device__ __forceinline__ void operator()(const f32x4 (&acc)[2][2][4][2], const Unit& u, int wr, int wc, int fr, int fq) const {
        const int row0 = u.pm * BM + wr * 64 + fr; const int col0 = u.pn * BM + wc * 32 + 8 * fq;
#pragma unroll
        for (int ai = 0; ai < 2; ++ai)
#pragma unroll
            for (int m = 0; m < 4; ++m) { const size_t off = (size_t)(row0 + ai * HALF + m * 16) * ldc + col0;
#pragma unroll
                for (int bj = 0; bj < 2; ++bj) {
                    const f32x4 x0 = *(const f32x4*)(X + off + bj * HALF), x1 = *(const f32x4*)(X + off + bj * HALF + 4);
                    *(f32x4*)(O + off + bj * HALF) = x0 + acc[ai][bj][m][0]; *(f32x4*)(O + off + bj * HALF + 4) = x1 + acc[ai][bj][m][1]; } }
    }
};

struct EpiNormQKV {
    bf16_t* O; size_t split_stride; const float* gq; const float* gk; float qscale; LAS float* xl;
    __device__ __forceinline__ void operator()(const f32x4 (&acc)[2][2][4][2], const Unit& u, int wr, int wc, int fr, int fq) const {
        const int row0 = u.pm * BM + wr * 64 + fr; const int colt = u.pn * BM; const int t = colt / 1024; bf16_t* base = O + (size_t)t * split_stride; const int cin = colt - t * 1024;
        const int col0 = cin + wc * 32 + 8 * fq;
        if (t < 2) {
#pragma unroll
            for (int ai = 0; ai < 2; ++ai)
#pragma unroll
                for (int m = 0; m < 4; ++m)
#pragma unroll
                    for (int bj = 0; bj < 2; ++bj) { const f32x4 a = acc[ai][bj][m][0], b = acc[ai][bj][m][1];
                        float s = (a[0] * a[0] + a[1] * a[1]) + (a[2] * a[2] + a[3] * a[3]) + (b[0] * b[0] + b[1] * b[1]) + (b[2] * b[2] + b[3] * b[3]);
                        s += __shfl_xor(s, 16); s += __shfl_xor(s, 32);
                        if (fq == 0) xl[((ai * HALF + wr * 64 + m * 16 + fr) * 2 + bj) * 4 + wc] = s; }
        }
        asm volatile("s_waitcnt lgkmcnt(0)" ::: "memory"); __builtin_amdgcn_s_barrier(); asm volatile("" ::: "memory");
        const float sc = t == 0 ? qscale : 1.f;
        const float* gn = t == 0 ? gq : gk;
        f32x4 g0 = {1.f, 1.f, 1.f, 1.f}, g1 = g0;
        if (t < 2) { g0 = *(const f32x4*)(gn + wc * 32 + 8 * fq); g1 = *(const f32x4*)(gn + wc * 32 + 8 * fq + 4); }
#pragma unroll
        for (int ai = 0; ai < 2; ++ai)
#pragma unroll
            for (int m = 0; m < 4; ++m) { bf16_t* rowp = base + (size_t)(row0 + ai * HALF + m * 16) * 1024 + col0;
#pragma unroll
                for (int bj = 0; bj < 2; ++bj) { f32x4 v0 = acc[ai][bj][m][0], v1 = acc[ai][bj][m][1];
                    if (t < 2) { const f32x4 p = *(const LAS f32x4*)(xl + ((ai * HALF + wr * 64 + m * 16 + fr) * 2 + bj) * 4);
                        const float r = sc / sqrtf(((p[0] + p[1]) + (p[2] + p[3])) * (1.f / 128.f) + EPS); v0 = v0 * r * g0; v1 = v1 * r * g1; }
                    u32x4 w; w.x = cvt_pk_bf16(v0[0], v0[1]); w.y = cvt_pk_bf16(v0[2], v0[3]); w.z = cvt_pk_bf16(v1[0], v1[1]); w.w = cvt_pk_bf16(v1[2], v1[3]);
                    *(u32x4*)(rowp + bj * HALF) = w; }
                asm volatile("" ::: "memory"); }
        asm volatile("s_waitcnt lgkmcnt(0)" ::: "memory"); __builtin_amdgcn_s_barrier(); asm volatile("" ::: "memory");
    }
};

template <class Epi, bool DUAL = false>
__device__ __forceinline__ void gemm_phase(LAS unsigned char* lds, const Gemm g, const StaticOrder& S, const Epi& E, int tid) {
    const int wid = __builtin_amdgcn_readfirstlane(tid >> 6), lane = tid & 63, wr = wid >> 2, wc = wid & 3, fr = lane & 15, fq = lane >> 4;
    const int K = g.K, nt = K / BK;
    unsigned voffA[2], voffB[2];
#pragma unroll
    for (int i = 0; i < 2; ++i) { int R, C; stage_rc(tid * 16 + i * 8192, R, C); const int Rb = (R & ~31) + perm32(R & 31);
        voffA[i] = (unsigned)(R * g.lda + C) * 2u; voffB[i] = (unsigned)(Rb * g.ldb + C) * 2u; }
    const size_t kstep = (size_t)(BK * 2);
    const size_t hA = (size_t)HALF * g.lda * 2, hB = (size_t)HALF * g.ldb * 2;
    const size_t tA = 2 * hA, tB = 2 * hB;
    const unsigned ldsw = (unsigned)wid * 1024u;
    const int aoff = lds_byte(wr * 64 + fr, fq * 8), boff = lds_byte(wc * 32 + fr, fq * 8);
#define PG8_SA(b, h) (((b) * 2 + (h)) * HTB)
#define PG8_SB(b, h) ((4 + (b) * 2 + (h)) * HTB)
#define PG8_STAGE(bufoff, gbase, voff) do { _Pragma("unroll") for (int _i = 0; _i < 2; ++_i) \
        __builtin_amdgcn_global_load_lds((const unsigned*)((const char*)(gbase) + (voff)[_i]), (LAS unsigned*)(lds + (bufoff) + ldsw + _i * 8192), 16, 0, 0); } while (0)
#define PG8_LDA(dst, b, h) do { _Pragma("unroll") for (int m = 0; m < 4; ++m) _Pragma("unroll") for (int k = 0; k < 2; ++k) dst[m][k] = *(const LAS bf16x8*)(lds + PG8_SA(b, h) + aoff + m * 2048 + k * 1024); } while (0)
#define PG8_LDB(dst, b, h) do { _Pragma("unroll") for (int n = 0; n < 2; ++n) _Pragma("unroll") for (int k = 0; k < 2; ++k) dst[n][k] = *(const LAS bf16x8*)(lds + PG8_SB(b, h) + boff + n * 2048 + k * 1024); } while (0)
#define PG8_MMA(ai, bj, At, Bt) do { __builtin_amdgcn_s_setprio(1); _Pragma("unroll") for (int m = 0; m < 4; ++m) _Pragma("unroll") for (int n = 0; n < 2; ++n) _Pragma("unroll") for (int k = 0; k < 2; ++k) \
        acc[ai][bj][m][n] = __builtin_amdgcn_mfma_f32_16x16x32_bf16(Bt[n][k], At[m][k], acc[ai][bj][m][n], 0, 0, 0); __builtin_amdgcn_s_setprio(0); } while (0)
#define PG8_WAIT_V(n) asm volatile("s_waitcnt vmcnt(" #n ")" ::: "memory")
#define PG8_WAIT_L(n) asm volatile("s_waitcnt lgkmcnt(" #n ")" ::: "memory")
#define PG8_BAR __builtin_amdgcn_s_barrier()
#define PG8_SCHED __builtin_amdgcn_sched_barrier(0)
    Unit cur, nxt; int ui = 0;
    if (!S.next(0, cur)) return;
    f32x4 acc[2][2][4][2];
#pragma unroll
    for (int a = 0; a < 2; ++a)
#pragma unroll
        for (int b = 0; b < 2; ++b)
#pragma unroll
            for (int m = 0; m < 4; ++m)
#pragma unroll
                for (int n = 0; n < 2; ++n) acc[a][b][m][n] = (f32x4){0.f, 0.f, 0.f, 0.f};
    bf16x8 At[4][2], B0[2][2], B1[2][2];
    const char* cA = (const char*)g.A + (size_t)cur.pm * tA; const char* cB = (const char*)g.Bt + (size_t)cur.pn * tB;
    const int nt1 = DUAL ? g.K1 / BK : 0;
    const char* cA2 = DUAL ? (const char*)g.A2 + (size_t)cur.pm * tA : nullptr;
#define PG8_AAT(s) ((DUAL && (s) >= nt1) ? cA2 + (size_t)((s) - nt1) * kstep : cA + (size_t)(s) * kstep)
    PG8_STAGE(PG8_SB(0, 0), cB, voffB); PG8_STAGE(PG8_SB(0, 1), cB + hB, voffB); PG8_STAGE(PG8_SA(0, 0), cA, voffA); PG8_STAGE(PG8_SA(0, 1), cA + hA, voffA);
    if (wr == 1) PG8_BAR;
    PG8_WAIT_V(2); PG8_BAR;
    PG8_STAGE(PG8_SB(1, 0), cB + kstep, voffB); PG8_STAGE(PG8_SA(1, 0), cA + kstep, voffA); PG8_STAGE(PG8_SB(1, 1), cB + hB + kstep, voffB);
    PG8_WAIT_V(6); PG8_BAR;
    for (;;) {
        const bool has_next = S.next(ui + 1, nxt);
        const char* nA = has_next ? (const char*)g.A + (size_t)nxt.pm * tA : cA; const char* nB = has_next ? (const char*)g.Bt + (size_t)nxt.pn * tB : cB;
#pragma unroll 1
        for (int half_ = 0; half_ < (DUAL ? 2 : 1); ++half_) {
        if constexpr (DUAL) { if (half_ == 1) E.mid(acc, cur, wr, wc, fr, fq); }
        const int tbeg_ = (DUAL && half_ == 1) ? nt1 : 0, tend_ = (DUAL && half_ == 0) ? nt1 : nt;
#pragma unroll 1
        for (int t = tbeg_; t < tend_; t += 2) {
            const bool last = (t == nt - 2);
            const char* a1 = PG8_AAT(t + 1);
            const char* a2 = last ? nA : PG8_AAT(t + 2); const char* b2 = last ? nB : cB + (size_t)(t + 2) * kstep;
            const char* a3 = a2 + kstep; const char* b3 = b2 + kstep;
            PG8_LDB(B0, 0, 0); PG8_LDB(B1, 0, 1); PG8_SCHED; PG8_LDA(At, 0, 0); PG8_STAGE(PG8_SA(1, 1), a1 + hA, voffA);
            PG8_WAIT_V(8); PG8_WAIT_L(0); PG8_BAR; PG8_MMA(0, 0, At, B0); PG8_MMA(0, 1, At, B1); PG8_BAR; PG8_SCHED;
            PG8_LDA(At, 0, 1); PG8_STAGE(PG8_SB(0, 0), b2, voffB); PG8_STAGE(PG8_SB(0, 1), b2 + hB, voffB); PG8_STAGE(PG8_SA(0, 0), a2, voffA);
            PG8_WAIT_V(8); PG8_WAIT_L(0); PG8_BAR; PG8_MMA(1, 0, At, B0); PG8_MMA(1, 1, At, B1); PG8_BAR; PG8_SCHED;
            PG8_LDB(B0, 1, 0); PG8_LDB(B1, 1, 1); PG8_SCHED; PG8_LDA(At, 1, 0); PG8_STAGE(PG8_SA(0, 1), a2 + hA, voffA);
            PG8_WAIT_V(8); PG8_WAIT_L(0); PG8_BAR; PG8_MMA(0, 0, At, B0); PG8_MMA(0, 1, At, B1); PG8_BAR; PG8_SCHED;
            PG8_LDA(At, 1, 1); PG8_STAGE(PG8_SB(1, 0), b3, voffB); PG8_STAGE(PG8_SB(1, 1), b3 + hB, voffB); PG8_STAGE(PG8_SA(1, 0), a3, voffA);
            PG8_WAIT_V(8); PG8_WAIT_L(0); PG8_BAR; PG8_MMA(1, 0, At, B0); PG8_MMA(1, 1, At, B1); PG8_BAR; PG8_SCHED;
        }
        }
        if (wr == 0) PG8_BAR;
        E(acc, cur, wr, wc, fr, fq);
        if (!has_next) break;
#pragma unroll
        for (int a = 0; a < 2; ++a)
#pragma unroll
            for (int b = 0; b < 2; ++b)
#pragma unroll
                for (int m = 0; m < 4; ++m)
#pragma unroll
                    for (int n = 0; n < 2; ++n) acc[a][b][m][n] = (f32x4){0.f, 0.f, 0.f, 0.f};
        cur = nxt; cA = nA; cB = nB; ++ui; if constexpr (DUAL) cA2 = (const char*)g.A2 + (size_t)cur.pm * tA;
        if (wr == 1) PG8_BAR;
    }
    PG8_WAIT_V(0);
    PG8_BAR;
#undef PG8_AAT
#undef PG8_SA
#undef PG8_SB
#undef PG8_STAGE
#undef PG8_LDA
#undef PG8_LDB
#undef PG8_MMA
#undef PG8_WAIT_V
#undef PG8_WAIT_L
#undef PG8_BAR
#undef PG8_SCHED
}
}

namespace att {
constexpr int NW = 8, QBLK = 32, KVBLK = 64, QB = NW * QBLK;
constexpr int SHM_V = KVBLK * 128 * 2;
constexpr float THR2 = 11.5f;
#define KSWZ(row, colB) ((row) * 256 + ((colB) ^ (((row) & 7) << 4)))
#define KRSWZ(row, c) ((row) * 128 + ((((c) ^ (((row) >> 1) & 7))) << 4))
#define SBAR() __builtin_amdgcn_sched_barrier(0)
__device__ __forceinline__ int v_st(int k, int c) { const int kk = (k & ~0xC) | ((k & 4) << 1) | ((k & 8) >> 1); return ((kk >> 3) * 4 + (c >> 5)) * 512 + ((kk & 7) * 32 + (c & 31)) * 2; }
__device__ __forceinline__ int v_rd_base(int lane) { return ((lane & 3) << 3) | (((lane >> 2) & 3) << 6) | (((lane >> 4) & 1) << 5) | (((lane >> 5) & 1) << 8); }
constexpr int v_rd_off(int d0, int ks, int half) { return d0 * 512 + ks * 4096 + half * 2048; }
__device__ __forceinline__ int crow(int r, int hi) { return (r & 3) + 8 * (r >> 2) + 4 * hi; }
__device__ __forceinline__ unsigned cvtpk(float lo, float hi) { unsigned r; asm volatile("v_cvt_pk_bf16_f32 %0, %1, %2" : "=v"(r) : "v"(lo), "v"(hi)); return r; }

template <int DQK> struct Cfg {
    static constexpr int SHM_K = KVBLK * DQK * 2;
    static constexpr int OFF_K = 0, OFF_V = 2 * SHM_K, OFF_WS = OFF_V + 3 * SHM_V, OFF_BT = OFF_WS + NW * 64 * 4, OFF_QX = OFF_BT + 512 * 4;
    static constexpr int NQR = (DQK == 192 ? 8 : 8), NQX = DQK / 16 - NQR, QXW = NQX * 1024, LDS_NEED = OFF_QX + NW * QXW;
};
struct BlockRef { const bf16_t* Q; const bf16_t* K; const bf16_t* K2; const bf16_t* V; bf16_t* O; int P0; };
struct Seam { bf16x8 qr[8]; };

__device__ __forceinline__ void mask_tile(f32x16& p0, f32x16& p1, int dq) {
#pragma unroll
    for (int r = 0; r < 16; ++r) { const int c = (r & 3) + 8 * (r >> 2);
        p0[r] += __int_as_float(((dq - c) >> 31) & (int)0xFF800000);
        p1[r] += __int_as_float(((dq - c - 32) >> 31) & (int)0xFF800000); }
}
__device__ __forceinline__ void bias_tile(f32x16& p0, f32x16& p1, int dq, const float* bt) {
    const float* b = bt + (dq + 256 - 59);
#pragma unroll
    for (int r = 0; r < 16; ++r) { const int c = (r & 3) + 8 * (r >> 2);
        p0[r] += b[59 - c]; p1[r] += b[27 - c]; }
}
__device__ __forceinline__ void partialSM(f32x16& p0, f32x16& p1, float& m_reg, float& mn, float& alpha) {
    float pmax = p0[0];
#pragma unroll
    for (int r = 1; r < 16; ++r) pmax = fmaxf(pmax, p0[r]);
#pragma unroll
    for (int r = 0; r < 16; ++r) pmax = fmaxf(pmax, p1[r]);
    { auto rr = __builtin_amdgcn_permlane32_swap(__float_as_uint(pmax), __float_as_uint(pmax), false, false);
      pmax = fmaxf(__uint_as_float(rr[0]), __uint_as_float(rr[1])); }
    if (__builtin_expect(__all((pmax - m_reg) <= THR2), 1)) { mn = m_reg; alpha = 1.f; }
    else { mn = fmaxf(m_reg, pmax); alpha = __builtin_amdgcn_exp2f(m_reg - mn); m_reg = mn; }
#pragma unroll
    for (int r = 0; r < 16; ++r) p0[r] = p0[r] - mn;
#pragma unroll
    for (int r = 0; r < 16; ++r) p1[r] = p1[r] - mn;
#pragma unroll
    for (int r = 0; r < 16; ++r) p0[r] = __builtin_amdgcn_exp2f(p0[r]);
}
__device__ __forceinline__ void partialSMf(f32x16& p0, f32x16& p1, float negB) {
#pragma unroll
    for (int r = 0; r < 16; ++r) p0[r] = __builtin_amdgcn_exp2f(p0[r] + negB);
#pragma unroll
    for (int r = 0; r < 16; ++r) p1[r] = p1[r] + negB;
}
__device__ __forceinline__ void finishSM(f32x16& p0, f32x16& p1, float alpha, float& l_reg, bf16x8& pa0, bf16x8& pa1, bf16x8& pa2, bf16x8& pa3) {
#pragma unroll
    for (int r = 0; r < 16; ++r) p1[r] = __builtin_amdgcn_exp2f(p1[r]);
    float ps = 0;
#pragma unroll
    for (int r = 0; r < 16; ++r) ps += p0[r];
#pragma unroll
    for (int r = 0; r < 16; ++r) ps += p1[r];
    { auto rr = __builtin_amdgcn_permlane32_swap(__float_as_uint(ps), __float_as_uint(ps), false, false);
      ps = __uint_as_float(rr[0]) + __uint_as_float(rr[1]); }
    l_reg = l_reg * alpha + ps;
#define PK4(P, B_, OUT) do { unsigned a0 = cvtpk(P[B_+0], P[B_+1]), a1 = cvtpk(P[B_+2], P[B_+3]);                          \
        unsigned b0 = cvtpk(P[B_+4], P[B_+5]), b1 = cvtpk(P[B_+6], P[B_+7]);                                             \
        auto r0 = __builtin_amdgcn_permlane32_swap(a0, b0, false, false); auto r1 = __builtin_amdgcn_permlane32_swap(a1, b1, false, false); \
        u32x4 w = {r0[0], r1[0], r0[1], r1[1]}; OUT = *reinterpret_cast<bf16x8*>(&w); } while (0)
    PK4(p0, 0, pa0); PK4(p0, 8, pa1); PK4(p1, 0, pa2); PK4(p1, 8, pa3);
#undef PK4
}
template <int DQK, int KB>
__device__ __forceinline__ void qkt(f32x16& p0, f32x16& p1, const char* K_lds, const char* qx, int r32, int hi, const bf16x8* qr) {
    constexpr int SHM_K = Cfg<DQK>::SHM_K, NQR = Cfg<DQK>::NQR;
    p0 = f32x16{}; p1 = f32x16{};
    const char* kb[4];
#pragma unroll
    for (int dd = 0; dd < 4; ++dd) kb[dd] = K_lds + KB * SHM_K + KSWZ(r32, (dd * 16 + hi * 8) * 2);
#pragma unroll
    for (int d0 = 0; d0 < 8; ++d0) { const char* a = kb[d0 & 3] + (d0 >> 2) * 128;
        bf16x8 b0 = *reinterpret_cast<const bf16x8*>(a);
        bf16x8 b1 = *reinterpret_cast<const bf16x8*>(a + 32 * 256);
        bf16x8 q; if (d0 < NQR) q = qr[d0]; else q = *reinterpret_cast<const bf16x8*>(qx + (d0 - NQR) * 1024);
        p0 = __builtin_amdgcn_mfma_f32_32x32x16_bf16(b0, q, p0, 0, 0, 0);
        p1 = __builtin_amdgcn_mfma_f32_32x32x16_bf16(b1, q, p1, 0, 0, 0); }
    if constexpr (DQK == 192) {
#pragma unroll
        for (int dd = 0; dd < 4; ++dd) { const char* a = K_lds + KB * SHM_K + 16384 + KRSWZ(r32, dd * 2 + hi);
            bf16x8 b0 = *reinterpret_cast<const bf16x8*>(a);
            bf16x8 b1 = *reinterpret_cast<const bf16x8*>(a + 32 * 128);
            const bf16x8 q = *reinterpret_cast<const bf16x8*>(qx + (8 + dd - NQR) * 1024);
            p0 = __builtin_amdgcn_mfma_f32_32x32x16_bf16(b0, q, p0, 0, 0, 0);
            p1 = __builtin_amdgcn_mfma_f32_32x32x16_bf16(b1, q, p1, 0, 0, 0); }
    }
}
__device__ __forceinline__ void pv_tile(f32x16* o, int vb0, bf16x8 pa0, bf16x8 pa1, bf16x8 pa2, bf16x8 pa3) {
#define TRRD(dst, off) asm volatile("ds_read_b64_tr_b16 %0, %1 offset:%2" : "=&v"(dst) : "v"(vb0), "i"(off) : "memory")
#define PV_D0(d0) do { s16x4 l0, l1, l2, l3, h0, h1, h2, h3; constexpr int b_ = v_rd_off(d0, 0, 0); \
        TRRD(l0, b_); TRRD(h0, b_ + 2048); TRRD(l1, b_ + 4096); TRRD(h1, b_ + 6144); TRRD(l2, b_ + 8192); TRRD(h2, b_ + 10240); TRRD(l3, b_ + 12288); TRRD(h3, b_ + 14336); \
        asm volatile("s_waitcnt lgkmcnt(0)" ::: "memory"); SBAR();   \
        o[d0] = __builtin_amdgcn_mfma_f32_32x32x16_bf16((bf16x8){l0[0], l0[1], l0[2], l0[3], h0[0], h0[1], h0[2], h0[3]}, pa0, o[d0], 0, 0, 0);   \
        o[d0] = __builtin_amdgcn_mfma_f32_32x32x16_bf16((bf16x8){l1[0], l1[1], l1[2], l1[3], h1[0], h1[1], h1[2], h1[3]}, pa1, o[d0], 0, 0, 0);   \
        o[d0] = __builtin_amdgcn_mfma_f32_32x32x16_bf16((bf16x8){l2[0], l2[1], l2[2], l2[3], h2[0], h2[1], h2[2], h2[3]}, pa2, o[d0], 0, 0, 0);   \
        o[d0] = __builtin_amdgcn_mfma_f32_32x32x16_bf16((bf16x8){l3[0], l3[1], l3[2], l3[3], h3[0], h3[1], h3[2], h3[3]}, pa3, o[d0], 0, 0, 0); } while (0)
    PV_D0(0); PV_D0(1); PV_D0(2); PV_D0(3);
#undef PV_D0
#undef TRRD
}

__device__ __forceinline__ const bf16_t* uni_ptr(const bf16_t* p) {
    const unsigned long long v = (unsigned long long)p; const unsigned lo = __builtin_amdgcn_readfirstlane((unsigned)v), hi = __builtin_amdgcn_readfirstlane((unsigned)(v >> 32));
    return (const bf16_t*)(const GAS bf16_t*)(((unsigned long long)hi << 32) | lo); }
#define LD8B(base, off32) (*reinterpret_cast<const bf16x8*>((const char*)(base) + (size_t)(unsigned)(off32)))
#define VMW() asm volatile("s_waitcnt vmcnt(0)" ::: "memory")
#define VMWN(n) asm volatile("s_waitcnt vmcnt(%0)" :: "i"(n) : "memory")
#define SLOAD(Kp, K2p, Vp, k0) do { const bf16_t* vt_ = uni_ptr((Vp) + (size_t)(k0) * LDV); const bf16_t* kt_ = uni_ptr((Kp) + (size_t)(k0) * LDK);      \
        S.st_v0 = LD8B(vt_, ovk); S.st_v1 = LD8B(vt_ + 32 * LDV, ovk);                                                           \
        S.st_k0 = LD8B(kt_, okk); S.st_k1 = LD8B(kt_ + 32 * LDK, okk);                                                           \
        if constexpr (DQK == 192) S.st_k2 = LD8B(uni_ptr((K2p) + (size_t)(k0) * LDK2), ok2); } while (0)
#define SWRITE_K(bf) do { *(bf16x8*)(K_lds + (bf) * SHM_K + kws) = S.st_k0; *(bf16x8*)(K_lds + (bf) * SHM_K + kws + 32 * 256) = S.st_k1;   \
        if constexpr (DQK == 192) *(bf16x8*)(K_lds + (bf) * SHM_K + 16384 + krs) = S.st_k2; } while (0)
#define SWRITE_V(bf) do { char* vs_ = V_lds + (bf) * SHM_V; *(bf16x8*)(vs_ + vst0) = S.st_v0; *(bf16x8*)(vs_ + vst1) = S.st_v1; } while (0)
#define QLOAD(R) do { const bf16_t* qb_ = uni_ptr((R).Q + (size_t)(wid * QBLK) * LDQ);                                                \
        _Pragma("unroll") for (int d0 = 0; d0 < Cfg<DQK>::NQR; ++d0) S.qr[d0] = LD8B(qb_ + d0 * 16, oq); } while (0)
#define QX_FILL(R) do { if constexpr (Cfg<DQK>::NQX > 0) { const bf16_t* qb_ = uni_ptr((R).Q + (size_t)(wid * QBLK) * LDQ); bf16x8 qxr[Cfg<DQK>::NQX];  \
        _Pragma("unroll") for (int dd = 0; dd < Cfg<DQK>::NQX; ++dd) qxr[dd] = LD8B(qb_ + (Cfg<DQK>::NQR + dd) * 16, oq);                \
        VMW(); _Pragma("unroll") for (int dd = 0; dd < Cfg<DQK>::NQX; ++dd) *(bf16x8*)(qx + dd * 1024) = qxr[dd]; } } while (0)

template <int DQK, int LDQ, int LDK, int LDK2, int LDV>
__device__ __forceinline__ void attn_prime(const BlockRef& cur, char* lds, Seam& S, int tid_in) {
    const int tid = tid_in;
    const int wid = __builtin_amdgcn_readfirstlane(tid >> 6), lane = tid & 63, r32 = lane & 31, hi = lane >> 5;
    const unsigned oq = (unsigned)(r32 * LDQ + hi * 8) * 2u;
    char* qx = lds + Cfg<DQK>::OFF_QX + wid * Cfg<DQK>::QXW + lane * 16;
    QX_FILL(cur);
    QLOAD(cur);
    __syncthreads();
}
template <int DQK, bool BIAS, int LDQ, int LDK, int LDK2, int LDV, int LDO, class MK>
__device__ __forceinline__ void attn_block(const BlockRef& cur, int next_idx, const MK& mk, char* lds, Seam& S, int tid_in, float negB) {
    constexpr int SHM_K = Cfg<DQK>::SHM_K;
    const int tid = tid_in;
    const int wid = __builtin_amdgcn_readfirstlane(tid >> 6), lane = tid & 63, r32 = lane & 31, hi = lane >> 5;
    const int NT = (cur.P0 + QB - 1) / KVBLK + 1;
    const int qlo = cur.P0 + wid * QBLK, qm = qlo + r32 - 4 * hi;
    char* V_lds = lds + Cfg<DQK>::OFF_V; char* K_lds = lds + Cfg<DQK>::OFF_K;
    float* ws = (float*)(lds + Cfg<DQK>::OFF_WS) + wid * 64; float* li_l = ws, * al_l = ws + 32;
    const float* bt = (const float*)(lds + Cfg<DQK>::OFF_BT);
    char* qx = lds + Cfg<DQK>::OFF_QX + wid * Cfg<DQK>::QXW + lane * 16;
    float l_reg = 0; f32x16 o[4] = {};
    const unsigned oq = (unsigned)(r32 * LDQ + hi * 8) * 2u;
    const int vb0 = (int)(uintptr_t)V_lds + v_rd_base(lane);
    unsigned ks0, ks1, kr0, vs0, vs1;
    { const int ra = 8 * wid + (lane >> 4), rb = ra + 4; ks0 = (unsigned)(ra * LDK + ((lane & 15) ^ (ra & 7)) * 8) * 2u; ks1 = (unsigned)(rb * LDK + ((lane & 15) ^ (rb & 7)) * 8) * 2u;
      const int rr = 8 * wid + (lane >> 3); kr0 = (unsigned)(rr * LDK2 + ((lane & 7) ^ ((rr >> 1) & 7)) * 8) * 2u;
#define VSRC(sp) ({ const int sidx = 2 * (sp) + (lane >> 5), kk = (sidx >> 2) * 8 + ((lane & 31) >> 2), k = (kk & ~0xC) | ((kk & 4) << 1) | ((kk & 8) >> 1); (unsigned)(k * LDV + (sidx & 3) * 32 + (lane & 3) * 8) * 2u; })
      vs0 = VSRC(2 * wid); vs1 = VSRC(2 * wid + 1);
#undef VSRC
    }
    const bf16_t* Kh = cur.K; const bf16_t* K2h = cur.K2; const bf16_t* Vh = cur.V;
#define DMA_TILE(t, kslot, vslot) do { const char* kt_ = (const char*)uni_ptr(Kh + (size_t)((t) * KVBLK) * LDK); const char* vt_ = (const char*)uni_ptr(Vh + (size_t)((t) * KVBLK) * LDV);     \
        LAS char* kd_ = (LAS char*)K_lds + (kslot) * SHM_K; LAS char* vd_ = (LAS char*)V_lds + (vslot) * SHM_V + wid * 2048;                                                             \
        __builtin_amdgcn_global_load_lds((const unsigned*)(kt_ + ks0), (LAS unsigned*)(kd_ + wid * 2048), 16, 0, 0);                                                                       \
        __builtin_amdgcn_global_load_lds((const unsigned*)(kt_ + ks1), (LAS unsigned*)(kd_ + wid * 2048 + 1024), 16, 0, 0);                                                                \
        if constexpr (DQK == 192) { const char* k2_ = (const char*)uni_ptr(K2h + (size_t)((t) * KVBLK) * LDK2);                                                                           \
            __builtin_amdgcn_global_load_lds((const unsigned*)(k2_ + kr0), (LAS unsigned*)(kd_ + 16384 + wid * 1024), 16, 0, 0); }                                                          \
        __builtin_amdgcn_global_load_lds((const unsigned*)(vt_ + vs0), (LAS unsigned*)(vd_), 16, 0, 0);                                                                                    \
        __builtin_amdgcn_global_load_lds((const unsigned*)(vt_ + vs1), (LAS unsigned*)(vd_ + 1024), 16, 0, 0); } while (0)
#define RESC(a) do { if (__any((a) < 1.f)) { if (hi == 0) al_l[r32] = (a); asm volatile("s_waitcnt lgkmcnt(0)" ::: "memory");              \
                     for (int d_ = 0; d_ < 4; ++d_) for (int r = 0; r < 16; ++r) o[d_][r] *= al_l[crow(r, hi)]; } } while (0)
#define KBASE(t) ((t) * KVBLK)
#define MASKT(P0_, P1_, t) do { const int kb_ = KBASE(t); if constexpr (BIAS) { if (kb_ + KVBLK - 1 + 128 > qlo) bias_tile(P0_, P1_, qm - kb_, bt); } \
                                else { if (kb_ + KVBLK - 1 > qlo) mask_tile(P0_, P1_, qm - kb_); } } while (0)
    f32x16 pA0, pA1, pB0, pB1; bf16x8 pa0, pa1, pa2, pa3;
    DMA_TILE(0, 0, 0);
    __syncthreads();
    DMA_TILE(1, 1, 1);
    asm volatile("s_sleep 4" ::: "memory");
    SBAR(); qkt<DQK, 0>(pA0, pA1, K_lds, qx, r32, hi, S.qr);
    MASKT(pA0, pA1, 0); partialSMf(pA0, pA1, negB);
    __syncthreads();
    int rs = 0, wsl = 2;
#define STEP(PX0, PX1, PY0, PY1, t, KB, ORD) do {                                                              \
        if ((t) + 1 < NT) DMA_TILE((t) + 1, (KB) ^ 1, wsl);                                                                   \
        SBAR();                                                                                                               \
        if (ORD == 0) { const bool aq_ = KBASE(t) <= qlo + 31, ap_ = KBASE((t) - 1) <= qlo + 31;     \
                        if (aq_) qkt<DQK, KB>(PX0, PX1, K_lds, qx, r32, hi, S.qr);                                             \
                        if (ap_) { finishSM(PY0, PY1, 1.f, l_reg, pa0, pa1, pa2, pa3); SBAR(); pv_tile(o, vb0 + rs * SHM_V, pa0, pa1, pa2, pa3); }   \
                        if (aq_) { MASKT(PX0, PX1, (t)); partialSMf(PX0, PX1, negB); } }                                       \
        else { finishSM(PY0, PY1, 1.f, l_reg, pa0, pa1, pa2, pa3); SBAR();                                                    \
               qkt<DQK, KB>(PX0, PX1, K_lds, qx, r32, hi, S.qr); MASKT(PX0, PX1, (t)); partialSMf(PX0, PX1, negB); SBAR();      \
               pv_tile(o, vb0 + rs * SHM_V, pa0, pa1, pa2, pa3); }                                                 \
        __syncthreads();                                                                                                      \
        rs = rs == 2 ? 0 : rs + 1; wsl = wsl == 2 ? 0 : wsl + 1; } while (0)
    for (int t = 1; t + 1 < NT; t += 2) { STEP(pB0, pB1, pA0, pA1, t, 1, 0); STEP(pA0, pA1, pB0, pB1, t + 1, 0, 0); }
    STEP(pB0, pB1, pA0, pA1, NT - 1, 1, 0);
    if (KBASE(NT - 1) <= qlo + 31) { finishSM(pB0, pB1, 1.f, l_reg, pa0, pa1, pa2, pa3); SBAR(); pv_tile(o, vb0 + rs * SHM_V, pa0, pa1, pa2, pa3); }
    int nj_ = next_idx; asm volatile("" : "+s"(nj_)); const BlockRef nxt = mk(nj_);
    SBAR(); QLOAD(nxt); SBAR();
    { const float rl = __builtin_amdgcn_rcpf(l_reg);
      bf16_t* Ow = cur.O + (size_t)(wid * QBLK + r32) * LDO + hi * 8;
#pragma unroll
      for (int d0 = 0; d0 < 4; ++d0) {
#pragma unroll
          for (int pr = 0; pr < 2; ++pr) { const int b = 8 * pr;
              const unsigned a0 = cvtpk(o[d0][b] * rl, o[d0][b + 1] * rl), a1 = cvtpk(o[d0][b + 2] * rl, o[d0][b + 3] * rl), b0 = cvtpk(o[d0][b + 4] * rl, o[d0][b + 5] * rl), b1 = cvtpk(o[d0][b + 6] * rl, o[d0][b + 7] * rl);
              auto r0 = __builtin_amdgcn_permlane32_swap(a0, b0, false, false); auto r1 = __builtin_amdgcn_permlane32_swap(a1, b1, false, false);
              *(u32x4*)(Ow + d0 * 32 + pr * 16) = (u32x4){r0[0], r1[0], r0[1], r1[1]}; } } }
    QX_FILL(nxt);
    __syncthreads();
#undef RESC
#undef KBASE
#undef MASKT
#undef STEP
#undef DMA_TILE
}
#undef LD8B
#undef VMW
#undef VMWN
#undef SLOAD
#undef SWRITE_K
#undef SWRITE_V
#undef QLOAD
#undef QX_FILL
}

namespace daw {
using att::crow; using att::cvtpk;
constexpr int NW = 8, QBLK = 32, KVB = 32, QB = 256;
constexpr int SHM_V = KVB * 256 * 2, SHM_K = KVB * 128 * 2;
constexpr int OFF_K = 3 * SHM_V, OFF_WS = OFF_K + 2 * SHM_K, OFF_BT = OFF_WS + NW * 64 * 4, OFF_QL = OFF_BT + 512 * 4, LDS_NEED = OFF_QL + NW * 8192;
__device__ __forceinline__ int v_st2(int k, int c) { const int kk = (k & ~0xC) | ((k & 4) << 1) | ((k & 8) >> 1); return ((kk >> 3) * 8 + (c >> 5)) * 512 + ((kk & 7) * 32 + (c & 31)) * 2; }
struct BlockRef { const bf16_t* Q; const bf16_t* K; const bf16_t* V; bf16_t* O; int P0; };
struct Seam { bf16x8 st_v0, st_v1, st_k0; };
__device__ __forceinline__ void bias_tile1(f32x16& p0, int dq, const float* bt) {
    const float* b = bt + (dq + 256 - 27);
#pragma unroll
    for (int r = 0; r < 16; ++r) { const int c = (r & 3) + 8 * (r >> 2); p0[r] += b[27 - c]; }
}
__device__ __forceinline__ void partialSM1(f32x16& p0, float negB) {
#pragma unroll
    for (int r = 0; r < 8; ++r) p0[r] = __builtin_amdgcn_exp2f(p0[r] + negB);
}
__device__ __forceinline__ void finishSM1(f32x16& p0, float negB, float& l_reg, bf16x8& pa0, bf16x8& pa1) {
#pragma unroll
    for (int r = 8; r < 16; ++r) p0[r] = __builtin_amdgcn_exp2f(p0[r] + negB);
    float ps = 0;
#pragma unroll
    for (int r = 0; r < 16; ++r) ps += p0[r];
    l_reg += ps;
#define PK4(P, B_, OUT) do { unsigned a0 = cvtpk(P[B_+0], P[B_+1]), a1 = cvtpk(P[B_+2], P[B_+3]);                          \
        unsigned b0 = cvtpk(P[B_+4], P[B_+5]), b1 = cvtpk(P[B_+6], P[B_+7]);                                             \
        auto r0 = __builtin_amdgcn_permlane32_swap(a0, b0, false, false); auto r1 = __builtin_amdgcn_permlane32_swap(a1, b1, false, false); \
        u32x4 w = {r0[0], r1[0], r0[1], r1[1]}; OUT = *reinterpret_cast<bf16x8*>(&w); } while (0)
    PK4(p0, 0, pa0); PK4(p0, 8, pa1);
#undef PK4
}
struct QkAddr { int k0, k1, k2, k3, q; };
template <int KB>
__device__ __forceinline__ void qkt1(f32x16& p0, const QkAddr& A) {
#define RDK(dst, d0) asm volatile("ds_read_b128 %0, %1 offset:%2" : "=&v"(dst) : "v"(((d0) & 3) == 0 ? A.k0 : ((d0) & 3) == 1 ? A.k1 : ((d0) & 3) == 2 ? A.k2 : A.k3), "i"(KB * SHM_K + ((d0) >> 2) * 128) : "memory")
#define RDQ(dst, d0) asm volatile("ds_read_b128 %0, %1 offset:%2" : "=&v"(dst) : "v"(A.q), "i"((d0) * 1024) : "memory")
#define RD(S, d0) do { RDK(k##S, d0); RDQ(q##S, d0); } while (0)
#define MM(S) p0 = __builtin_amdgcn_mfma_f32_32x32x16_bf16(*reinterpret_cast<bf16x8*>(&k##S), *reinterpret_cast<bf16x8*>(&q##S), p0, 0, 0, 0)
#define WT(n) do { asm volatile("s_waitcnt lgkmcnt(" #n ")" ::: "memory"); SBAR(); } while (0)
    u32x4 kA, qA, kB, qB, kC, qC;
    p0 = f32x16{};
    RD(A, 0); RD(B, 1);
    RD(C, 2); WT(4); MM(A); SBAR();
    RD(A, 3); WT(4); MM(B); SBAR();
    RD(B, 4); WT(4); MM(C); SBAR();
    RD(C, 5); WT(4); MM(A); SBAR();
    RD(A, 6); WT(4); MM(B); SBAR();
    RD(B, 7); WT(4); MM(C); SBAR();
    WT(2); MM(A); SBAR();
    WT(0); MM(B);
#undef WT
#undef MM
#undef RD
#undef RDQ
#undef RDK
}
__device__ __forceinline__ void pv_tile1(f32x16* o, int vb, bf16x8 pa0, bf16x8 pa1) {
#define TRRD(dst, off) asm volatile("ds_read_b64_tr_b16 %0, %1 offset:%2" : "=&v"(dst) : "v"(vb), "i"(off) : "memory")
#define PV_RD(S, d0) do { constexpr int b_ = (d0) * 512; TRRD(S##0, b_); TRRD(S##1, b_ + 4096); TRRD(S##2, b_ + 8192); TRRD(S##3, b_ + 12288); } while (0)
#define PV_MM(S, d0) do { \
        o[d0] = __builtin_amdgcn_mfma_f32_32x32x16_bf16((bf16x8){S##0[0], S##0[1], S##0[2], S##0[3], S##1[0], S##1[1], S##1[2], S##1[3]}, pa0, o[d0], 0, 0, 0);   \
        o[d0] = __builtin_amdgcn_mfma_f32_32x32x16_bf16((bf16x8){S##2[0], S##2[1], S##2[2], S##2[3], S##3[0], S##3[1], S##3[2], S##3[3]}, pa1, o[d0], 0, 0, 0); } while (0)
#define PV_W4() do { asm volatile("s_waitcnt lgkmcnt(4)" ::: "memory"); SBAR(); } while (0)
    s16x4 ta0, ta1, ta2, ta3, tb0, tb1, tb2, tb3;
    PV_RD(ta, 0);
    PV_RD(tb, 1); PV_W4(); PV_MM(ta, 0); SBAR();
    PV_RD(ta, 2); PV_W4(); PV_MM(tb, 1); SBAR();
    PV_RD(tb, 3); PV_W4(); PV_MM(ta, 2); SBAR();
    PV_RD(ta, 4); PV_W4(); PV_MM(tb, 3); SBAR();
    PV_RD(tb, 5); PV_W4(); PV_MM(ta, 4); SBAR();
    PV_RD(ta, 6); PV_W4(); PV_MM(tb, 5); SBAR();
    PV_RD(tb, 7); PV_W4(); PV_MM(ta, 6); SBAR();
    asm volatile("s_waitcnt lgkmcnt(0)" ::: "memory"); SBAR(); PV_MM(tb, 7);
#undef PV_W4
#undef PV_MM
#undef PV_RD
#undef TRRD
}
#define LD8B(base, off32) (*reinterpret_cast<const bf16x8*>((const char*)(base) + (size_t)(unsigned)(off32)))
#define VMW() asm volatile("s_waitcnt vmcnt(0)" ::: "memory")
#define SLOAD(Kp, Vp, k0) do { const bf16_t* vt_ = att::uni_ptr((Vp) + (size_t)(k0) * LDV); const bf16_t* kt_ = att::uni_ptr((Kp) + (size_t)(k0) * LDK);      \
        S.st_v0 = LD8B(vt_, ovk); S.st_v1 = LD8B(vt_ + 128, ovk); S.st_k0 = LD8B(kt_, okk); } while (0)
#define SWRITE_K(bf) do { *(bf16x8*)(K_lds + (bf) * SHM_K + kws) = S.st_k0; } while (0)
#define SWRITE_V(bf) do { char* vs_ = V_lds + (bf) * SHM_V; *(bf16x8*)(vs_ + vst0) = S.st_v0; *(bf16x8*)(vs_ + vst1) = S.st_v1; } while (0)
#define Q_FILL(R) do { const bf16_t* qb_ = att::uni_ptr((R).Q + (size_t)(wid * QBLK) * LDQ); bf16x8 qxr[8];                              \
        _Pragma("unroll") for (int dd = 0; dd < 8; ++dd) qxr[dd] = LD8B(qb_ + dd * 16, oq);                                            \
        VMW(); _Pragma("unroll") for (int dd = 0; dd < 8; ++dd) *(bf16x8*)(ql + dd * 1024) = qxr[dd]; } while (0)

template <int LDQ, int LDK, int LDV>
__device__ __forceinline__ void prime(const BlockRef& cur, char* lds, int tid) {
    const int wid = __builtin_amdgcn_readfirstlane(tid >> 6), lane = tid & 63, r32 = lane & 31, hi = lane >> 5;
    const unsigned oq = (unsigned)(r32 * LDQ + hi * 8) * 2u;
    char* ql = lds + OFF_QL + wid * 8192 + lane * 16;
    Q_FILL(cur);
    __syncthreads();
}
template <int LDQ, int LDK, int LDV, int LDO, class MK>
__device__ __forceinline__ void block(const BlockRef& cur, int next_idx, const MK& mk, char* lds, int tid, float negB) {
    const int wid = __builtin_amdgcn_readfirstlane(tid >> 6), lane = tid & 63, r32 = lane & 31, hi = lane >> 5;
    const int NT = (cur.P0 + QB) / KVB;
    const int qlo = cur.P0 + wid * QBLK, qm = qlo + r32 - 4 * hi;
    char* V_lds = lds; char* K_lds = lds + OFF_K;
    float* ws = (float*)(lds + OFF_WS) + wid * 64; float* li_l = ws;
    const float* bt = (const float*)(lds + OFF_BT);
    char* ql = lds + OFF_QL + wid * 8192 + lane * 16;
    float l_reg = 0; f32x16 o[8] = {};
    const unsigned oq = (unsigned)(r32 * LDQ + hi * 8) * 2u;
    const int vb0 = (int)(uintptr_t)V_lds + att::v_rd_base(lane);
    unsigned ksrc, vsrc0, vsrc1;
    { const int r = 4 * wid + (lane >> 4), c16 = (lane & 15) ^ (r & 7); ksrc = (unsigned)(r * LDK + c16 * 8) * 2u;
#define VSRC(sp) ({ const int sidx = 2 * (sp) + (lane >> 5), kk = (sidx >> 3) * 8 + ((lane & 31) >> 2), k = (kk & ~0xC) | ((kk & 4) << 1) | ((kk & 8) >> 1); (unsigned)(k * LDV + (sidx & 7) * 32 + (lane & 3) * 8) * 2u; })
      vsrc0 = VSRC(2 * wid); vsrc1 = VSRC(2 * wid + 1);
#undef VSRC
    }
    const bf16_t* Kh = cur.K; const bf16_t* Vh = cur.V;
#define DMA_TILE(t, kslot, vslot) do { const char* kt_ = (const char*)att::uni_ptr(Kh + (size_t)((t) * KVB) * LDK); const char* vt_ = (const char*)att::uni_ptr(Vh + (size_t)((t) * KVB) * LDV);   \
        LAS unsigned* kd_ = (LAS unsigned*)((LAS char*)K_lds + (kslot) * SHM_K + wid * 1024); LAS unsigned* vd_ = (LAS unsigned*)((LAS char*)V_lds + (vslot) * SHM_V + wid * 2048);        \
        __builtin_amdgcn_global_load_lds((const unsigned*)(kt_ + ksrc), kd_, 16, 0, 0);                                                                                                   \
        __builtin_amdgcn_global_load_lds((const unsigned*)(vt_ + vsrc0), vd_, 16, 0, 0);                                                                                                  \
        __builtin_amdgcn_global_load_lds((const unsigned*)(vt_ + vsrc1), (LAS unsigned*)((LAS char*)vd_ + 1024), 16, 0, 0); } while (0)
#define KBASE(t) ((t) * KVB)
#define MASKT(P0_, t) do { const int kb_ = KBASE(t); if (kb_ + KVB - 1 + 128 > qlo) bias_tile1(P0_, qm - kb_, bt); } while (0)
    f32x16 pA0, pB0; bf16x8 pa0, pa1;
    QkAddr qka;
    { const int kb_ = (int)(uintptr_t)K_lds; qka.k0 = kb_ + KSWZ(r32, (0 * 16 + hi * 8) * 2); qka.k1 = kb_ + KSWZ(r32, (1 * 16 + hi * 8) * 2); qka.k2 = kb_ + KSWZ(r32, (2 * 16 + hi * 8) * 2);
      qka.k3 = kb_ + KSWZ(r32, (3 * 16 + hi * 8) * 2); qka.q = (int)(uintptr_t)ql; }
    DMA_TILE(0, 0, 0);
    __syncthreads();
    DMA_TILE(1, 1, 1);
    asm volatile("s_sleep 4" ::: "memory");
    SBAR(); qkt1<0>(pA0, qka);
    MASKT(pA0, 0); partialSM1(pA0, negB);
    __syncthreads();
    int rs = 0, wsl = 2;
#define STEP(PX0, PY0, t, KB, ORD) do {                                                                                       \
        if ((t) + 1 < NT) DMA_TILE((t) + 1, (KB) ^ 1, wsl);                                                                   \
        SBAR();                                                                                                               \
        if (ORD == 0) { const bool aq_ = KBASE(t) <= qlo + 31, ap_ = KBASE((t) - 1) <= qlo + 31;     \
                        if (aq_) qkt1<KB>(PX0, qka);                                                                          \
                        if (ap_) { finishSM1(PY0, negB, l_reg, pa0, pa1); SBAR(); pv_tile1(o, vb0 + rs * SHM_V, pa0, pa1); }    \
                        if (aq_) { MASKT(PX0, (t)); partialSM1(PX0, negB); } }                                                \
        else          { finishSM1(PY0, negB, l_reg, pa0, pa1); SBAR(); qkt1<KB>(PX0, qka);                      \
                        MASKT(PX0, (t)); partialSM1(PX0, negB); SBAR(); pv_tile1(o, vb0 + rs * SHM_V, pa0, pa1); }            \
        __syncthreads();                                                                                                      \
        rs = rs == 2 ? 0 : rs + 1; wsl = wsl == 2 ? 0 : wsl + 1; } while (0)
    {
        for (int t = 1; t + 1 < NT; t += 2) { STEP(pB0, pA0, t, 1, 0); STEP(pA0, pB0, t + 1, 0, 0); }
        STEP(pB0, pA0, NT - 1, 1, 0);
    }
    if (KBASE(NT - 1) <= qlo + 31) { finishSM1(pB0, negB, l_reg, pa0, pa1); SBAR(); pv_tile1(o, vb0 + rs * SHM_V, pa0, pa1); }
    int nj_ = next_idx; asm volatile("" : "+s"(nj_)); const BlockRef nxt = mk(nj_);
    { auto rr = __builtin_amdgcn_permlane32_swap(__float_as_uint(l_reg), __float_as_uint(l_reg), false, false); l_reg = __uint_as_float(rr[0]) + __uint_as_float(rr[1]); }
    { const float rl = __builtin_amdgcn_rcpf(l_reg);
      bf16_t* Ow = cur.O + (size_t)(wid * QBLK + r32) * LDO + hi * 8;
#pragma unroll
      for (int d0 = 0; d0 < 8; ++d0) {
#pragma unroll
          for (int pr = 0; pr < 2; ++pr) { const int b = 8 * pr;
              const unsigned a0 = cvtpk(o[d0][b] * rl, o[d0][b + 1] * rl), a1 = cvtpk(o[d0][b + 2] * rl, o[d0][b + 3] * rl), b0 = cvtpk(o[d0][b + 4] * rl, o[d0][b + 5] * rl), b1 = cvtpk(o[d0][b + 6] * rl, o[d0][b + 7] * rl);
              auto r0 = __builtin_amdgcn_permlane32_swap(a0, b0, false, false); auto r1 = __builtin_amdgcn_permlane32_swap(a1, b1, false, false);
              *(u32x4*)(Ow + d0 * 32 + pr * 16) = (u32x4){r0[0], r1[0], r0[1], r1[1]}; } } }
    Q_FILL(nxt);
    __syncthreads();
#undef KBASE
#undef MASKT
#undef STEP
#undef DMA_TILE
}
#undef LD8B
#undef VMW
#undef SLOAD
#undef SWRITE_K
#undef SWRITE_V
#undef Q_FILL
}

struct Args { const float* in[25]; float* out; unsigned char* ws; };
enum { I_X = 0, I_WIN, I_ATTN_NORM, I_DA_QN, I_DA_KN, I_LQ1, I_LK1, I_LQ2, I_LK2, I_DA_ON, I_DA_PROJ, I_MLA_QLN, I_MLA_WUQ, I_MLA_KVLN, I_MLA_WUKV,
       I_MLA_QN, I_MLA_KN, I_MLA_PROJ, I_WOUT, I_RELB, I_FFN_NORM, I_PEER_WQ, I_PEER_KEYS, I_PEER_U, I_PEER_V };

struct Ctx {
    LAS unsigned char* lds; int tid, lane, wave, vcu, G, gw, NGW;
};

__device__ __forceinline__ void tr_item(const float* W, int K, int N, int src0, bf16_t* WT, int dst0, int nblk, LAS float* scr, int item, int lane, int ldw, int kofs, const float* kgain) {
    const int kb = item / nblk, nb = item % nblk, k0 = 64 * kb, n0 = 32 * nb;
#pragma unroll 8
    for (int i = 0; i < 32; ++i) { const int kk = 2 * i + (lane >> 5); scr[kk * 33 + (lane & 31)] = W[(size_t)(k0 + kk) * N + src0 + n0 + (lane & 31)]; }
    asm volatile("s_waitcnt lgkmcnt(0)" ::: "memory");
    const int c = lane & 7;
    f32x4 g0 = {1.f, 1.f, 1.f, 1.f}, g1 = g0;
    if (kgain) { g0 = *(const f32x4*)(kgain + k0 + 8 * c); g1 = *(const f32x4*)(kgain + k0 + 8 * c + 4); }
#pragma unroll
    for (int j = 0; j < 4; ++j) { const int n = (lane >> 3) + 8 * j; const LAS float* s = scr + (8 * c) * 33 + n;
        u32x4 o; o.x = cvt_pk_bf16(s[0 * 33] * g0[0], s[1 * 33] * g0[1]); o.y = cvt_pk_bf16(s[2 * 33] * g0[2], s[3 * 33] * g0[3]); o.z = cvt_pk_bf16(s[4 * 33] * g1[0], s[5 * 33] * g1[1]); o.w = cvt_pk_bf16(s[6 * 33] * g1[2], s[7 * 33] * g1[3]);
        *(u32x4*)(WT + (size_t)(dst0 + n0 + n) * ldw + kofs + k0 + 8 * c) = o; }
    asm volatile("s_waitcnt lgkmcnt(0)" ::: "memory");
}
__device__ __forceinline__ void tr_seg(const Ctx& C, LAS float* scr, const float* W, int K, int N, int src0, int width, bf16_t* WT, int dst0, int& base, int ldw = 0, int kofs = 0, const float* kgain = nullptr) {
    if (ldw == 0) ldw = K;
    const int nblk = width / 32, nitems = (K / 64) * nblk;
    int first = (C.gw - base) % C.NGW; if (first < 0) first += C.NGW;
    for (int it = first; it < nitems; it += C.NGW) tr_item(W, K, N, src0, WT, dst0, nblk, scr, it, C.lane, ldw, kofs, kgain);
    base = (base + nitems) % C.NGW;
}
__device__ __forceinline__ void rms_row_f32_to_bf16(const float* xrow, const float* gain, bf16_t* orow, int lane) {
    const f32x4* xr = (const f32x4*)xrow + lane; const f32x4* gr = (const f32x4*)gain + lane;
    f32x4 v[4]; float s = 0.f;
#pragma unroll
    for (int j = 0; j < 4; ++j) { v[j] = xr[64 * j]; s += (v[j].x * v[j].x + v[j].y * v[j].y) + (v[j].z * v[j].z + v[j].w * v[j].w); }
    const float rstd = 1.f / sqrtf(wave_sum(s) * (1.f / 1024.f) + EPS);
    u32x2* o8 = (u32x2*)orow + lane;
#pragma unroll
    for (int j = 0; j < 4; ++j) { const f32x4 g = gr[64 * j]; u32x2 w; w.x = cvt_pk_bf16(v[j].x * rstd * g.x, v[j].y * rstd * g.y); w.y = cvt_pk_bf16(v[j].z * rstd * g.z, v[j].w * rstd * g.w); o8[64 * j] = w; }
}
__device__ __forceinline__ float rope_invf(int i) { return exp2f(-(float)i * (13.287712379549449f / 32.f)); }

__device__ __forceinline__ unsigned vsel(unsigned long long m, unsigned a, unsigned b) { unsigned r; asm("v_cndmask_b32 %0, %1, %2, %3" : "=v"(r) : "v"(b), "v"(a), "s"(m)); return r; }
#define CE_DESC(a, b) do { const float _h = fmaxf(a, b); b = fminf(a, b); a = _h; } while (0)
__device__ __forceinline__ void topk_insert(float (&top)[16], float v) {
#pragma unroll
    for (int j = 0; j < 16; ++j) { const float h = fmaxf(top[j], v); v = fminf(top[j], v); top[j] = h; }
}
__device__ __forceinline__ void bitonic_sort16_desc(float (&a)[16]) {
#pragma unroll
    for (int d = 8; d >= 1; d >>= 1)
#pragma unroll
        for (int i = 0; i < 16; ++i) if ((i & d) == 0) CE_DESC(a[i], a[i + d]);
}
__device__ __forceinline__ void full_sort16_desc(float (&a)[16]) {
#pragma unroll
    for (int k = 2; k <= 16; k <<= 1)
#pragma unroll
        for (int j = k >> 1; j > 0; j >>= 1)
#pragma unroll
            for (int i = 0; i < 16; ++i) { const int l = i ^ j; if (l > i) { if (((i & k) == 0) || k == 16) CE_DESC(a[i], a[l]); else CE_DESC(a[l], a[i]); } }
}
__device__ __forceinline__ void merge_top16(float (&a)[16], const float (&b)[16]) {
#pragma unroll
    for (int j = 0; j < 16; ++j) a[j] = fmaxf(a[j], b[15 - j]);
    bitonic_sort16_desc(a);
}
__device__ __forceinline__ void half_top16(const f32x16 (&acc)[4], int hi, float (&top)[16]) {
    float g[4][16];
#pragma unroll
    for (int tl = 0; tl < 4; ++tl) {
#pragma unroll
        for (int r = 0; r < 16; ++r) { const unsigned key = (unsigned)(tl * 32 + (r & 3) + 8 * (r >> 2)) + 4u * (unsigned)hi;
            g[tl][r] = __uint_as_float((__float_as_uint(acc[tl][r]) & 0xFFFFFF80u) | key); }
        full_sort16_desc(g[tl]); }
    merge_top16(g[0], g[1]); merge_top16(g[2], g[3]); merge_top16(g[0], g[2]);
    float oth[16]; const unsigned long long mhi = __ballot(hi != 0);
#pragma unroll
    for (int j = 0; j < 16; ++j) { auto rr = __builtin_amdgcn_permlane32_swap(__float_as_uint(g[0][j]), __float_as_uint(g[0][j]), false, false);
        oth[j] = __uint_as_float(vsel(mhi, rr[0], rr[1])); top[j] = g[0][j]; }
    merge_top16(top, oth);
}
__device__ __forceinline__ unsigned sel16(const float (&a)[16], unsigned i) {
    const unsigned long long m8 = __ballot((i & 8u) != 0u), m4 = __ballot((i & 4u) != 0u), m2 = __ballot((i & 2u) != 0u), m1 = __ballot((i & 1u) != 0u);
    unsigned v[8];
#pragma unroll
    for (int j = 0; j < 8; ++j) v[j] = vsel(m8, __float_as_uint(a[j + 8]), __float_as_uint(a[j]));
#pragma unroll
    for (int j = 0; j < 4; ++j) v[j] = vsel(m4, v[j + 4], v[j]);
#pragma unroll
    for (int j = 0; j < 2; ++j) v[j] = vsel(m2, v[j + 2], v[j]);
    return vsel(m1, v[1], v[0]) & 127u;
}
__device__ __forceinline__ void p7_topk(const Ctx& C, const bf16_t* QP, const bf16_t* KEYS, int* EIDX, float* GATE) {
    const int lane = C.lane, r32 = lane & 31, hi = lane >> 5;
    const bool split = (C.G % 8) == 0;
    const int h0 = split ? (C.vcu & 7) : 0, hstep = split ? 8 : 1;
    const int wg_i = split ? (C.vcu >> 3) : C.vcu, wg_n = split ? (C.G >> 3) : C.G;
    for (int h = h0; h < 8; h += hstep) {
        __syncthreads();
        { const bf16_t* kp = KEYS + (size_t)h * 2 * 128 * 128;
#pragma unroll
          for (int i = 0; i < 8; ++i) { const int ch = C.tid + i * 512; const int row = ch >> 4, c16 = ch & 15;
              const u32x4 v = *(const u32x4*)(kp + (size_t)row * 128 + c16 * 8);
              *(LAS u32x4*)(C.lds + row * 256 + ((c16 ^ (row & 7)) << 4)) = v; } }
        __syncthreads();
    bf16x8 bq[16];
#define P7_QLOAD(tl_) do { const bf16_t* qp_ = QP + (size_t)((tl_) * 32 + r32) * 2048 + h * 256 + hi * 8;               \
        _Pragma("unroll") for (int ks = 0; ks < 8; ++ks) { bq[ks] = *(const bf16x8*)(qp_ + ks * 16); bq[8 + ks] = *(const bf16x8*)(qp_ + 128 + ks * 16); } } while (0)
    for (int tile = wg_i * 8 + C.wave; tile < T / 32; tile += wg_n * 8) {
        const int t0 = tile * 32;
        float s1[16], s2[16];
        P7_QLOAD(tile);
#pragma unroll
        for (int c = 0; c < 2; ++c) {
            f32x16 acc[4] = {};
#pragma unroll
            for (int ks = 0; ks < 8; ++ks) {
#pragma unroll
                for (int tl = 0; tl < 4; ++tl) { const int row = c * 128 + tl * 32 + r32;
                    const bf16x8 a = *(const LAS bf16x8*)(C.lds + row * 256 + (((ks * 2 + hi) ^ (row & 7)) << 4));
                    acc[tl] = __builtin_amdgcn_mfma_f32_32x32x16_bf16(a, bq[c * 8 + ks], acc[tl], 0, 0, 0); }
                if (ks & 1) __builtin_amdgcn_sched_barrier(0);
            }
            if (c == 0) half_top16(acc, hi, s1); else half_top16(acc, hi, s2);
        }
        float s1v[16], s2v[16];
#pragma unroll
        for (int j = 0; j < 16; ++j) { s1v[j] = __uint_as_float(__float_as_uint(s1[j]) & 0xFFFFFF80u); s2v[j] = __uint_as_float(__float_as_uint(s2[j]) & 0xFFFFFF80u); }
#define CAND(i, j) __uint_as_float((__float_as_uint(s1v[i] + s2v[j]) & 0xFFFFFF00u) | (unsigned)((i) * 16 + (j)))
        float top[16], y1[16], y2[16];
#pragma unroll
        for (int j = 0; j < 16; ++j) top[j] = CAND(0, j);
#pragma unroll
        for (int j = 0; j < 8; ++j) { y1[j] = CAND(1, j); y1[15 - j] = CAND(8 + j, 0); }
        bitonic_sort16_desc(y1);
        y2[0] = CAND(2, 0); y2[1] = CAND(2, 1); y2[2] = CAND(2, 2); y2[3] = CAND(2, 3); y2[4] = CAND(2, 4);
        y2[5] = CAND(3, 0); y2[6] = CAND(3, 1); y2[7] = CAND(3, 2); y2[8] = CAND(3, 3);
        y2[9] = CAND(4, 0); y2[10] = CAND(4, 1); y2[11] = CAND(4, 2);
        y2[12] = CAND(5, 0); y2[13] = CAND(5, 1); y2[14] = CAND(6, 0); y2[15] = CAND(6, 1);
        full_sort16_desc(y2);
        merge_top16(top, y1); merge_top16(top, y2);
        topk_insert(top, CAND(7, 0)); topk_insert(top, CAND(7, 1));
#undef CAND
        float w[16]; float sum = 0.f; const float v0 = __uint_as_float(__float_as_uint(top[0]) & 0xFFFFFF00u);
#pragma unroll
        for (int k = 0; k < 16; ++k) { const float v = __uint_as_float(__float_as_uint(top[k]) & 0xFFFFFF00u); w[k] = __expf(v - v0); sum += w[k]; }
        const float inv = 1.f / sum;
        const unsigned long long mhi = __ballot(hi != 0);
        int eo[8]; float go[8];
#pragma unroll
        for (int k = 0; k < 8; ++k) { const unsigned tv = vsel(mhi, __float_as_uint(top[k + 8]), __float_as_uint(top[k])); const float wv = __uint_as_float(vsel(mhi, __float_as_uint(w[k + 8]), __float_as_uint(w[k])));
            const unsigned id = tv & 255u;
            eo[k] = (int)(sel16(s1, id >> 4) * 128u + sel16(s2, id & 15u)); go[k] = wv * inv; }
        const size_t ob = ((size_t)(t0 + r32) * 8 + h) * 16 + hi * 8;
        *(int4*)(EIDX + ob) = make_int4(eo[0], eo[1], eo[2], eo[3]); *(int4*)(EIDX + ob + 4) = make_int4(eo[4], eo[5], eo[6], eo[7]);
        *(float4*)(GATE + ob) = make_float4(go[0], go[1], go[2], go[3]); *(float4*)(GATE + ob + 4) = make_float4(go[4], go[5], go[6], go[7]);
    }
#undef P7_QLOAD
    }
}

__device__ __forceinline__ float gelu_erf(float v) {
    const float t = __builtin_amdgcn_rcpf(fabsf(v) * 0.2316418882f + 1.0f);
    float q = t * 0.5307027145f + (-0.7265760135f); q = q * t + 0.7107068705f; q = q * t + (-0.142248368f); q = q * t + 0.127414796f; q = q * t;
    const float e = __builtin_amdgcn_exp2f((v * v) * (-0.72134752044f));
    const float m = v * (q * e);
    return v < 0.f ? m : v - m;
}
__device__ __forceinline__ void p8_gather(const Ctx& C, const bf16_t* H2, const unsigned char* UT8, const unsigned char* VT8, const unsigned* SCP,
                                          const int* EIDX, const float* GATE, float* out) {
    const int lane = C.lane, l5 = lane & 31, half = lane >> 5;
    const unsigned long long m32 = __ballot((lane & 32) != 0), m16 = __ballot((lane & 16) != 0), m8 = __ballot((lane & 8) != 0);
    LAS int* LISTE = (LAS int*)(C.lds + C.wave * 3072) + half * 128; LAS float* LISTG = (LAS float*)(C.lds + C.wave * 3072 + 1024) + half * 128; LAS float* LISTS = (LAS float*)(C.lds + C.wave * 3072 + 2048) + half * 128;
    for (int tp = C.gw; tp < T / 2; tp += C.NGW) {
        const int t = 2 * tp + half;
        unsigned hw[16];
        { const bf16_t* hp = H2 + (size_t)t * 1024 + 32 * l5;
          const u32x4 h0 = *(const u32x4*)hp, h1 = *(const u32x4*)(hp + 8), h2_ = *(const u32x4*)(hp + 16), h3 = *(const u32x4*)(hp + 24);
          hw[0] = h0.x; hw[1] = h0.y; hw[2] = h0.z; hw[3] = h0.w; hw[4] = h1.x; hw[5] = h1.y; hw[6] = h1.z; hw[7] = h1.w;
          hw[8] = h2_.x; hw[9] = h2_.y; hw[10] = h2_.z; hw[11] = h2_.w; hw[12] = h3.x; hw[13] = h3.y; hw[14] = h3.z; hw[15] = h3.w; }
        int ev[4]; float gv[4];
#pragma unroll
        for (int k = 0; k < 4; ++k) { ev[k] = EIDX[(size_t)t * 128 + 32 * k + l5]; gv[k] = GATE[(size_t)t * 128 + 32 * k + l5]; }
        unsigned sp4[4];
#pragma unroll
        for (int k = 0; k < 4; ++k) sp4[k] = SCP[ev[k]];
        f32x32 acc;
#pragma unroll
        for (int e = 0; e < 32; ++e) acc[e] = 0.f;
        { int base = 0, pos[4] = {0, 0, 0, 0};
          const unsigned lmask = (1u << l5) - 1u;
#pragma unroll
          for (int bb = 0; bb < 16; ++bb) {
#pragma unroll
              for (int k = 0; k < 4; ++k) { const bool mine = (ev[k] >> 10) == bb; const unsigned long long m = __ballot(mine);
                  const unsigned mh = (unsigned)(half ? (m >> 32) : m);
                  if (mine) pos[k] = base + __popc(mh & lmask);
                  base += __popc(mh); } }
#pragma unroll
          for (int k = 0; k < 4; ++k) { LISTE[pos[k]] = ev[k]; LISTG[pos[k]] = gv[k] * bf_hi(sp4[k]); LISTS[pos[k]] = bf_lo(sp4[k]); } }
#define P8_LDU(DST, lb) do { _Pragma("unroll") for (int j = 0; j < 4; ++j) { const int e = LISTE[(lb) + j];                                  \
            const unsigned* up = (const unsigned*)(UT8 + (size_t)e * 768 + 24 * l5); const u32x4 x = *(const u32x4*)up; const u32x2 y = *(const u32x2*)(up + 4); \
            DST[j] = (u32x6){x.x, x.y, x.z, x.w, y.x, y.y}; } } while (0)
#define P8_BATCH(UR, UN, b) do {                                                                                                            \
            const int lbase = (b) * 4;                                                                                                      \
            u32x6 vr[4];                                                                                                                    \
            _Pragma("unroll") for (int j = 0; j < 4; ++j) { const int e = LISTE[lbase + j];                                                 \
                const unsigned* vp = (const unsigned*)(VT8 + (size_t)e * 768 + 24 * l5); const u32x4 x2 = *(const u32x4*)vp; const u32x2 y2 = *(const u32x2*)(vp + 4); \
                vr[j] = (u32x6){x2.x, x2.y, x2.z, x2.w, y2.x, y2.y}; }                                                                      \
            if ((b) + 1 < 32) P8_LDU(UN, lbase + 4);                                                                                        \
            const int kmine = (lane >> 3) & 3;                                                                                              \
            const float gmine = LISTG[lbase + kmine], su = LISTS[lbase + kmine];                        \
            float p[4];                                                                                                                     \
            _Pragma("unroll") for (int j = 0; j < 4; ++j) { const bf16x32v ub_ = __builtin_amdgcn_cvt_scalef32_pk32_bf16_fp6(UR[j], 1.0f); FP6_SETTLE(); float sa = 0.f, sb = 0.f;     \
                _Pragma("unroll") for (int e = 0; e < 16; e += 2) { const bf16x2v up_ = {ub_[2 * e], ub_[2 * e + 1]}, uq_ = {ub_[2 * e + 2], ub_[2 * e + 3]};                       \
                    sa = __builtin_amdgcn_fdot2_f32_bf16(up_, __builtin_bit_cast(bf16x2v, hw[e]), sa, false); sb = __builtin_amdgcn_fdot2_f32_bf16(uq_, __builtin_bit_cast(bf16x2v, hw[e + 1]), sb, false); } \
                p[j] = sa + sb; }                                                                                                                 \
              \
              \
            float q2[2];                                                                                                                    \
            _Pragma("unroll") for (int j = 0; j < 2; ++j) { auto rr_ = __builtin_amdgcn_permlane16_swap(__float_as_uint(p[j]), __float_as_uint(p[j + 2]), false, false); q2[j] = __uint_as_float(rr_[0]) + __uint_as_float(rr_[1]); } \
            float d;                                                                                                                        \
            { const float snd = __uint_as_float(vsel(m8, __float_as_uint(q2[0]), __float_as_uint(q2[1]))), kp = __uint_as_float(vsel(m8, __float_as_uint(q2[1]), __float_as_uint(q2[0]))); \
              d = kp + __int_as_float(__builtin_amdgcn_update_dpp(0, __float_as_int(snd), 0x128, 0xF, 0xF, false)); }                        \
            d += __int_as_float(__builtin_amdgcn_update_dpp(0, __float_as_int(d), 0xB1, 0xF, 0xF, false));                                  \
            d += __int_as_float(__builtin_amdgcn_update_dpp(0, __float_as_int(d), 0x4E, 0xF, 0xF, false));                                  \
            d += __int_as_float(__builtin_amdgcn_update_dpp(0, __float_as_int(d), 0x141, 0xF, 0xF, false));                                 \
            const float xx = d * su; const float wmine = gelu_erf(xx) * gmine;                  \
            _Pragma("unroll") for (int j = 0; j < 4; ++j) { const unsigned wa = __builtin_amdgcn_readlane(__float_as_uint(wmine), 8 * j), wb = __builtin_amdgcn_readlane(__float_as_uint(wmine), 32 + 8 * j); \
                const float wgt = __uint_as_float(vsel(m32, wb, wa));                                                                       \
                const f32x32 vf = __builtin_amdgcn_cvt_scalef32_pk32_f32_fp6(vr[j], 1.0f); FP6_SETTLE();                                    \
                _Pragma("unroll") for (int e = 0; e < 32; ++e) acc[e] = fmaf(wgt, vf[e], acc[e]); } } while (0)
        { u32x6 ua[4], ub[4];
          P8_LDU(ua, 0);
#pragma unroll 1
          for (int b = 0; b < 32; b += 2) { P8_BATCH(ua, ub, b); P8_BATCH(ub, ua, b + 1); } }
#undef P8_BATCH
#undef P8_LDU
        { float* orow = out + (size_t)t * 1024 + 32 * l5;
#pragma unroll
            for (int q = 0; q < 8; ++q) { f32x4 x = *(const f32x4*)(orow + 4 * q); x += (f32x4){acc[4 * q], acc[4 * q + 1], acc[4 * q + 2], acc[4 * q + 3]}; *(f32x4*)(orow + 4 * q) = x; } }
    }
}

__device__ __forceinline__ Ctx mkctx(LAS unsigned char* lds, int wave0) {
    Ctx C; int w_ = wave0; asm volatile("" : "+s"(w_)); int tid = w_ * 64 + (int)__builtin_amdgcn_mbcnt_hi(~0u, __builtin_amdgcn_mbcnt_lo(~0u, 0u)); asm volatile("" : "+v"(tid));
    C.lds = lds; C.tid = tid; C.lane = tid & 63; C.wave = __builtin_amdgcn_readfirstlane(tid >> 6);
    C.G = gridDim.x; { const int bx = blockIdx.x; C.vcu = (C.G % 8 == 0) ? (bx % 8) * (C.G / 8) + bx / 8 : bx; }
    C.gw = C.vcu * NWAVES + C.wave; C.NGW = C.G * NWAVES; return C;
}
__device__ __forceinline__ unsigned long long ptr_from_lds(volatile LAS unsigned long long* PT, int i) {
    const unsigned long long v = PT[i];
    const unsigned lo = __builtin_amdgcn_readfirstlane((unsigned)v), hi = __builtin_amdgcn_readfirstlane((unsigned)(v >> 32));
    return ((unsigned long long)hi << 32) | lo;
}
#define DEF_PTRS \
    const Ctx C = mkctx(ldsb, wave0); const int lane = C.lane; (void)lane; \
    unsigned char* ws = WSP(); \
    const float* x = IN(I_X); \
    bf16_t* WinA = (bf16_t*)(ws + WS_WINA); bf16_t* WinB = (bf16_t*)(ws + WS_WINB); bf16_t* Wuq = (bf16_t*)(ws + WS_WUQ); bf16_t* Wukv = (bf16_t*)(ws + WS_WUKV); \
    bf16_t* Wda = (bf16_t*)(ws + WS_WDA); bf16_t* Wmla = (bf16_t*)(ws + WS_WMLA); bf16_t* Wout = (bf16_t*)(ws + WS_WOUT); bf16_t* Wq = (bf16_t*)(ws + WS_WQ); \
    bf16_t* KEYS = (bf16_t*)(ws + WS_KEYS); \
    bf16_t* XN = (bf16_t*)(ws + WS_A); bf16_t* YA = XN; bf16_t* H2 = XN; \
    bf16_t* OB = (bf16_t*)(ws + WS_B); \
    bf16_t* LAT = (bf16_t*)(ws + WS_LAT); bf16_t* QM = (bf16_t*)(ws + WS_QM); bf16_t* KN = (bf16_t*)(ws + WS_KN); bf16_t* VM = (bf16_t*)(ws + WS_VM); bf16_t* KRH = (bf16_t*)(ws + WS_KRH); \
    bf16_t* QA = (bf16_t*)(ws + WS_QA); bf16_t* KA = (bf16_t*)(ws + WS_KA); bf16_t* VA = (bf16_t*)(ws + WS_VA); bf16_t* OA = (bf16_t*)(ws + WS_OA); \
    bf16_t* MERGED = (bf16_t*)(ws + WS_MERGED); bf16_t* UT = (bf16_t*)(ws + WS_UT); bf16_t* VT = (bf16_t*)(ws + WS_VT); bf16_t* QP = (bf16_t*)(ws + WS_QP); \
    int* EIDX = (int*)(ws + WS_EIDX); float* GATE = (float*)(ws + WS_GATE); \
    unsigned char* UT8 = ws + WS_UT8; unsigned char* VT8 = ws + WS_VT8; float* SCU = (float*)(ws + WS_SCU); float* SCV = (float*)(ws + WS_SCV); unsigned* SCP = (unsigned*)(ws + WS_SCP); (void)SCP; float* SSQL = (float*)(ws + WS_SSQL); \
    bf16_t* GATES = (bf16_t*)OUTP(); \
    float* out = OUTP();
#ifndef PHMASK
#define PHMASK 0x1FFFF
#endif
#ifndef REPMASK
#define REPMASK 0
#endif
#ifndef REPTAIL
#define REPTAIL 1
#endif
__global__ void __launch_bounds__(NWAVES * 64, 2) mega_fwd(Args args) {
    extern __shared__ __attribute__((aligned(16))) unsigned char lds[];
    cg::grid_group grid = cg::this_grid();
    LAS unsigned char* const ldsb = (LAS unsigned char*)lds;
    const int wave0 = __builtin_amdgcn_readfirstlane((int)threadIdx.x >> 6);
    const Ctx C = mkctx(ldsb, wave0);
    unsigned* ctl = (unsigned*)args.ws;
    for (int u = C.tid; u < (LDS_BYTES - LDSCTL_OFF) / 4; u += NWAVES * 64) ((LAS unsigned*)(C.lds + LDSCTL_OFF))[u] = 0u;
    __syncthreads();
    if (__builtin_expect(args.ws == nullptr, 0)) grid.sync();
    XcdBarrier bar = xcd_barrier_post(ctl + CW_BAR, (volatile LAS unsigned*)(C.lds + MISC_OFF) + 8, C.tid);
#define GRID_BAR() do { const Ctx Cb = mkctx(ldsb, wave0); xcd_barrier(bar, Cb.tid); } while (0)

    volatile LAS unsigned long long* PT = (volatile LAS unsigned long long*)(C.lds + LDSCTL_OFF + 512);
    if (C.tid == 0) {
#define PTW(i) PT[i] = (unsigned long long)args.in[i];
        PTW(0) PTW(1) PTW(2) PTW(3) PTW(4) PTW(5) PTW(6) PTW(7) PTW(8) PTW(9) PTW(10) PTW(11) PTW(12) PTW(13) PTW(14) PTW(15) PTW(16) PTW(17) PTW(18) PTW(19) PTW(20) PTW(21) PTW(22) PTW(23) PTW(24)
#undef PTW
        PT[25] = (unsigned long long)args.out; PT[26] = (unsigned long long)args.ws;
    }
    __syncthreads();
#define PTR64(i) ptr_from_lds(PT, (i))
#define IN(i) ((const float*)(const GAS float*)PTR64(i))
#define OUTP() ((float*)(GAS float*)PTR64(25))
#define WSP() ((unsigned char*)(GAS unsigned char*)PTR64(26))

#pragma unroll 1
    for (int rep_ = 0; rep_ < (int)((REPMASK >> 0) & 1) + 1; ++rep_) {
#if (PHMASK >> 0) & 1
    { DEF_PTRS
    {
        LAS float* scr = (LAS float*)(C.lds + C.wave * 16384);
        int base = 0;
        const float* w_in = IN(I_WIN);
        tr_seg(C, scr, w_in, 1024, IN_COLS, 0, 3072, WinB, 0, base);
        tr_seg(C, scr, w_in, 1024, IN_COLS, 3776, 2048, WinA, 0, base);
        tr_seg(C, scr, w_in, 1024, IN_COLS, 3072, 384, WinA, 2048, base);
        tr_seg(C, scr, w_in, 1024, IN_COLS, 3456, 256, WinA, 2048 + 512, base);
        tr_seg(C, scr, w_in, 1024, IN_COLS, 3712, 64, WinA, 2048 + 768, base);
        tr_seg(C, scr, IN(I_MLA_WUQ), 384, 1536, 0, 1536, Wuq, 0, base, 0, 0, IN(I_MLA_QLN));
        for (int h = 0; h < 8; ++h) {
            tr_seg(C, scr, IN(I_MLA_WUKV), 256, 2048, h * 256, 128, Wukv, h * 128, base, 0, 0, IN(I_MLA_KVLN));
            tr_seg(C, scr, IN(I_MLA_WUKV), 256, 2048, h * 256 + 128, 128, Wukv, 1024 + h * 128, base, 0, 0, IN(I_MLA_KVLN));
        }
        tr_seg(C, scr, IN(I_DA_PROJ), 1024, 1024, 0, 1024, Wda, 0, base, 2048, 0);
        tr_seg(C, scr, IN(I_MLA_PROJ), 1024, 1024, 0, 1024, Wda, 0, base, 2048, 1024);
        tr_seg(C, scr, IN(I_WOUT), 1024, 1024, 0, 1024, Wout, 0, base);
        tr_seg(C, scr, IN(I_PEER_WQ), 1024, 2048, 0, 2048, Wq, 0, base);
        for (int i = C.gw * 64 + lane; i < (128 + 192) * 1024 / 8; i += C.NGW * 64) {
            const int r = i / 128, c8 = i % 128; const int row = r < 128 ? 2048 + 384 + r : 2048 + 832 + (r - 128);
            *(u32x4*)(WinA + (size_t)row * 1024 + c8 * 8) = (u32x4){0u, 0u, 0u, 0u}; }
        { const float* sk = IN(I_PEER_KEYS);
          for (int i = C.gw * 64 + lane; i < 262144 / 8; i += C.NGW * 64) { const f32x4 a = *(const f32x4*)(sk + (size_t)i * 8), b = *(const f32x4*)(sk + (size_t)i * 8 + 4);
              u32x4 w; w.x = cvt_pk_bf16(a.x, a.y); w.y = cvt_pk_bf16(a.z, a.w); w.z = cvt_pk_bf16(b.x, b.y); w.w = cvt_pk_bf16(b.z, b.w); *(u32x4*)(KEYS + (size_t)i * 8) = w; } }
        for (int m = C.gw; m < T; m += C.NGW) rms_row_f32_to_bf16(x + (size_t)m * 1024, IN(I_ATTN_NORM), XN + (size_t)m * 1024, lane);
    }
    }
#endif
    GRID_BAR();
    }

#pragma unroll 1
    for (int rep_ = 0; rep_ < (int)((REPMASK >> 1) & 1) + 1; ++rep_) {
#if (PHMASK >> 1) & 1
    { DEF_PTRS
    {
        pg8::Gemm g{XN, WinA, T, 3072, 1024, 1024, 1024}; pg8::StaticOrder S; S.init(T, 3072, C.G, (int)blockIdx.x);
        pg8::EpiStoreSS E{GATES, 2048, 2048, LAT, 1024, SSQL};
        pg8::gemm_phase<pg8::EpiStoreSS>(C.lds, g, S, E, C.tid);
    }
    }
#endif
    GRID_BAR();
    }
#pragma unroll 1
    for (int rep_ = 0; rep_ < (int)((REPMASK >> 3) & 1) + 1; ++rep_) {
#if (PHMASK >> 3) & 1
    { DEF_PTRS
    {
        pg8::Gemm g{LAT, Wuq, T, 1536, 384, 1024, 384}; pg8::StaticOrder S; S.init(T, 1536, C.G, (int)blockIdx.x);
        pg8::EpiRowScale E{QM, 1536, 0, 0, SSQL, 0, 8, 1.f / 384.f};
        pg8::gemm_phase<pg8::EpiRowScale>(C.lds, g, S, E, C.tid);
    }
    {
        pg8::Gemm g{LAT + 512, Wukv, T, 2048, 256, 1024, 256}; pg8::StaticOrder S; S.init(T, 2048, C.G, (int)blockIdx.x);
        pg8::EpiRowScale E{KN, 1024, 1024, (size_t)(WS_VM - WS_KN) / 2, SSQL, 8, 4, 1.f / 256.f};
        pg8::gemm_phase<pg8::EpiRowScale>(C.lds, g, S, E, C.tid);
    }
    }
#endif
    GRID_BAR();
    }
#pragma unroll 1
    for (int rep_ = 0; rep_ < (int)((REPMASK >> 4) & 1) + 1; ++rep_) {
#if (PHMASK >> 4) & 1
    { DEF_PTRS
    {
        const float* gq = IN(I_MLA_QN); const float* gk = IN(I_MLA_KN);
        const int hd = lane >> 3, j = lane & 7;
        for (int t = C.gw; t < T; t += C.NGW) {
            const float pos = (float)(t & (SEQ - 1));
            bf16_t* qrow = QM + (size_t)t * 1536 + hd * 192;
            const u32x4 a = *(const u32x4*)(qrow + 16 * j), b = *(const u32x4*)(qrow + 16 * j + 8), r = *(const u32x4*)(qrow + 128 + 8 * j);
            float v[16], rv[8]; unpack16(a, b, v); unpack8(r, rv);
            float pr[8];
#pragma unroll
            for (int e = 0; e < 8; ++e) pr[e] = __shfl_xor(rv[e], 4);
            float ro[8]; float snv[8], csv[8];
#pragma unroll
            for (int e = 0; e < 8; ++e) { const int i = (j & 3) * 8 + e; float sn, cs; sincosf(pos * rope_invf(i), &sn, &cs); snv[e] = sn; csv[e] = cs;
                ro[e] = (j < 4) ? (rv[e] * cs - pr[e] * sn) : (pr[e] * sn + rv[e] * cs); }
            float ss = 0.f;
#pragma unroll
            for (int e = 0; e < 16; ++e) ss += v[e] * v[e];
#pragma unroll
            for (int e = 0; e < 8; ++e) ss += ro[e] * ro[e];
            ss = grp_sum8(ss);
            const float rstd = QSCALE_MLA / sqrtf(ss * (1.f / 192.f) + EPS);
            float o[16], o2[8];
#pragma unroll
            for (int e = 0; e < 16; ++e) o[e] = v[e] * rstd * gq[16 * j + e];
#pragma unroll
            for (int e = 0; e < 8; ++e) o2[e] = ro[e] * rstd * gq[128 + 8 * j + e];
            *(u32x4*)(qrow + 16 * j) = pack8f(o); *(u32x4*)(qrow + 16 * j + 8) = pack8f(o + 8); *(u32x4*)(qrow + 128 + 8 * j) = pack8f(o2);
            bf16_t* krow = KN + (size_t)t * 1024 + hd * 128 + 16 * j;
            const u32x4 ka = *(const u32x4*)krow, kb = *(const u32x4*)(krow + 8), kr = *(const u32x4*)(LAT + (size_t)t * 1024 + 768 + 8 * j);
            float kv[16], krw[8], krv[8]; unpack16(ka, kb, kv); unpack8(kr, krw);
#pragma unroll
            for (int e = 0; e < 8; ++e) { const float kp = __shfl_xor(krw[e], 4); krv[e] = (j < 4) ? (krw[e] * csv[e] - kp * snv[e]) : (kp * snv[e] + krw[e] * csv[e]); }
            float ks = 0.f;
#pragma unroll
            for (int e = 0; e < 16; ++e) ks += kv[e] * kv[e];
#pragma unroll
            for (int e = 0; e < 8; ++e) ks += krv[e] * krv[e];
            ks = grp_sum8(ks);
            const float krstd = 1.f / sqrtf(ks * (1.f / 192.f) + EPS);
            float ko[16], ko2[8];
#pragma unroll
            for (int e = 0; e < 16; ++e) ko[e] = kv[e] * krstd * gk[16 * j + e];
#pragma unroll
            for (int e = 0; e < 8; ++e) ko2[e] = krv[e] * krstd * gk[128 + 8 * j + e];
            *(u32x4*)krow = pack8f(ko); *(u32x4*)(krow + 8) = pack8f(ko + 8);
            *(u32x4*)(KRH + (size_t)t * 512 + hd * 64 + 8 * j) = pack8f(ko2);
        }
    }
    }
#endif
    GRID_BAR();
    }
#pragma unroll 1
    for (int rep_ = 0; rep_ < (int)((REPMASK >> 5) & 1) + 1; ++rep_) {
#if (PHMASK >> 5) & 1
    { DEF_PTRS
    {
        char* alds = (char*)lds;
        const int head = C.vcu >> 4, xq = C.vcu & 15, b = head >> 3, h = head & 7;
        att::Seam S;
        auto mk = [&](int k) { const int qb = k == 0 ? 31 - xq : xq; att::BlockRef r;
            r.Q = QM + ((size_t)b * SEQ + (size_t)qb * 256) * 1536 + h * 192; r.K = KN + (size_t)b * SEQ * 1024 + h * 128; r.K2 = KRH + (size_t)b * SEQ * 512 + h * 64;
            r.V = VM + (size_t)b * SEQ * 1024 + h * 128; r.O = OB + ((size_t)b * SEQ + (size_t)qb * 256) * 1024 + h * 128; r.P0 = qb * 256; return r; };
        float negB;
        { const float* gq = IN(I_MLA_QN); const float* gk = IN(I_MLA_KN);
          float mq = fmaxf(fmaxf(fabsf(gq[lane]), fabsf(gq[lane + 64])), fabsf(gq[lane + 128])), mk_ = fmaxf(fmaxf(fabsf(gk[lane]), fabsf(gk[lane + 64])), fabsf(gk[lane + 128]));
#pragma unroll
          for (int o = 1; o < 64; o <<= 1) { mq = fmaxf(mq, __shfl_xor(mq, o)); mk_ = fmaxf(mk_, __shfl_xor(mk_, o)); }
          negB = -(192.f * mq * mk_ * QSCALE_MLA * 1.02f + 0.25f); }
        if (C.vcu < 256) {
            { const att::BlockRef cur = mk(0); att::attn_prime<192, 1536, 1024, 512, 1024>(cur, alds, S, C.tid); }
#pragma unroll 1
            for (int k = 0; k < 2; ++k) { int kk = k; asm volatile("" : "+s"(kk)); const att::BlockRef cur = mk(kk);
                att::attn_block<192, false, 1536, 1024, 512, 1024, 1024>(cur, 1, mk, alds, S, C.tid, negB); }
        }
    }
    }
#endif
    GRID_BAR();
    }
#pragma unroll 1
    for (int rep_ = 0; rep_ < (int)((REPMASK >> 6) & 1) + 1; ++rep_) {
#if (PHMASK >> 6) & 1
    { DEF_PTRS
    {
        pg8::Gemm g{XN, WinB, T, 3072, 1024, 1024, 1024}; pg8::StaticOrder S; S.init(T, 3072, C.G, (int)blockIdx.x);
        pg8::EpiNormQKV E{QA, (size_t)(WS_KA - WS_QA) / 2, IN(I_DA_QN), IN(I_DA_KN), QSCALE_DA, (LAS float*)(C.lds + 131072)};
        pg8::gemm_phase<pg8::EpiNormQKV>(C.lds, g, S, E, C.tid);
    }
    }
#endif
    GRID_BAR();
    }
#pragma unroll 1
    for (int rep_ = 0; rep_ < (int)((REPMASK >> 8) & 1) + 1; ++rep_) {
#if (PHMASK >> 8) & 1
    { DEF_PTRS
    {
        char* alds = (char*)lds;
        const int g8 = C.vcu >> 5, c = C.vcu & 31, b = g8 >> 2, h = g8 & 3;
        { float* bt = (float*)(alds + daw::OFF_BT); const float* rb = IN(I_RELB);
          const int i = C.tid; const int dist = i - 256; float val;
          if (dist < 0) val = -__builtin_inff();
          else { int bk; if (dist < 16) bk = dist; else { bk = 16; const int thr[15] = {19, 21, 24, 27, 31, 35, 40, 46, 52, 59, 67, 77, 87, 99, 113};
#pragma unroll
                  for (int q = 0; q < 15; ++q) bk += (dist >= thr[q]) ? 1 : 0; }
              val = (rb[bk * 4 + h] - rb[31 * 4 + h]) * LOG2E; }
          bt[i] = val; }
        auto mk = [&](int k) { const int m = c >> 4, xq = c & 15; const int qb = (k & 1) ? xq : 31 - xq;
            daw::BlockRef r;
            r.Q = QA + ((size_t)b * SEQ + (size_t)qb * 256) * 1024 + (h * 2 + m) * 128; r.K = KA + (size_t)b * SEQ * 1024 + (h * 2 + m) * 128;
            r.V = VA + (size_t)b * SEQ * 1024 + h * 256; r.O = OA + ((size_t)b * SEQ + (size_t)qb * 256) * 2048 + h * 512 + m * 256; r.P0 = qb * 256; return r; };
        float negB;
        { const float* gq = IN(I_DA_QN); const float* gk = IN(I_DA_KN); const float* rb = IN(I_RELB);
          float mq = fmaxf(fabsf(gq[lane]), fabsf(gq[lane + 64])), mk_ = fmaxf(fabsf(gk[lane]), fabsf(gk[lane + 64]));
          float mb = (rb[(lane & 31) * 4 + h] - rb[31 * 4 + h]) * LOG2E;
#pragma unroll
          for (int o = 1; o < 64; o <<= 1) { mq = fmaxf(mq, __shfl_xor(mq, o)); mk_ = fmaxf(mk_, __shfl_xor(mk_, o)); mb = fmaxf(mb, __shfl_xor(mb, o)); }
          negB = -(128.f * mq * mk_ * QSCALE_DA * 1.02f + 0.25f + fmaxf(mb, 0.f)); }
        if (C.vcu < 256) {
            { const daw::BlockRef cur = mk(0); daw::prime<1024, 1024, 1024>(cur, alds, C.tid); }
#pragma unroll 1
            for (int k = 0; k < 2; ++k) { int kk = k; asm volatile("" : "+s"(kk)); const daw::BlockRef cur = mk(kk);
                daw::block<1024, 1024, 1024, 2048>(cur, 1, mk, alds, C.tid, negB); }
        }
    }
    }
#endif
    GRID_BAR();
    }
#pragma unroll 1
    for (int rep_ = 0; rep_ < (int)((REPMASK >> 9) & 1) + 1; ++rep_) {
#if (PHMASK >> 9) & 1
    { DEF_PTRS
    {
        float lam;
        { const float q1 = IN(I_LQ1)[lane] * IN(I_LK1)[lane] + IN(I_LQ1)[lane + 64] * IN(I_LK1)[lane + 64];
          const float q2 = IN(I_LQ2)[lane] * IN(I_LK2)[lane] + IN(I_LQ2)[lane + 64] * IN(I_LK2)[lane + 64];
          lam = expf(wave_sum(q1)) - expf(wave_sum(q2)) + 0.2f; }
        const float* gn = IN(I_DA_ON);
        const int hd = lane >> 4, jj = lane & 15;
        for (int t = C.gw; t < T; t += C.NGW) {
            const bf16_t* r0 = OA + (size_t)t * 2048 + hd * 512 + 16 * jj;
            const u32x4 a0 = *(const u32x4*)r0, b0 = *(const u32x4*)(r0 + 8), a1 = *(const u32x4*)(r0 + 256), b1 = *(const u32x4*)(r0 + 264);
            float v0[16], v1[16]; unpack16(a0, b0, v0); unpack16(a1, b1, v1);
            float y[16]; float ss = 0.f;
#pragma unroll
            for (int e = 0; e < 16; ++e) { y[e] = v0[e] - lam * v1[e]; ss += y[e] * y[e]; }
            ss = grp_sum16(ss);
            const float rstd = 0.8f / sqrtf(ss * (1.f / 256.f) + EPS);
#pragma unroll
            for (int e = 0; e < 16; ++e) y[e] = y[e] * rstd * gn[16 * jj + e];
            bf16_t* orow = YA + (size_t)t * 1024 + hd * 256 + 16 * jj;
            *(u32x4*)orow = pack8f(y); *(u32x4*)(orow + 8) = pack8f(y + 8);
        }
        const float* pu = IN(I_PEER_U); const float* pv = IN(I_PEER_V);
        for (int r2 = C.gw; r2 < 16384; r2 += C.NGW) {
            const int r = r2 * 2 + (lane >> 5), tb = r >> 14, e = r & 16383, l5 = lane & 31;
            const float* src_ = (tb ? pv : pu) + (size_t)e * 1024 + 32 * l5;
            f32x16 xa, xb; float am = 0.f;
#pragma unroll
            for (int q = 0; q < 4; ++q) { const f32x4 a = *(const f32x4*)(src_ + 4 * q), b = *(const f32x4*)(src_ + 16 + 4 * q);
                xa[2 * q] = a.x; xb[2 * q] = a.y; xa[2 * q + 1] = a.z; xb[2 * q + 1] = a.w; xa[8 + 2 * q] = b.x; xb[8 + 2 * q] = b.y; xa[8 + 2 * q + 1] = b.z; xb[8 + 2 * q + 1] = b.w;
                am = fmaxf(am, fmaxf(fmaxf(fmaxf(fabsf(a.x), fabsf(a.y)), fmaxf(fabsf(a.z), fabsf(a.w))), fmaxf(fmaxf(fabsf(b.x), fabsf(b.y)), fmaxf(fabsf(b.z), fabsf(b.w))))); }
#pragma unroll
            for (int o = 1; o < 32; o <<= 1) am = fmaxf(am, __shfl_xor(am, o));
            const float sc = am > 0.f ? 7.5f / am : 0.f;
            const u32x6 w = __builtin_amdgcn_cvt_scalef32_2xpk16_fp6_f32(xa * sc, xb * sc, 1.0f); FP6_SETTLE();
            unsigned* dst = (unsigned*)((tb ? VT8 : UT8) + (size_t)e * 768 + 24 * l5);
            *(u32x2*)dst = (u32x2){w[0], w[1]}; *(u32x2*)(dst + 2) = (u32x2){w[2], w[3]}; *(u32x2*)(dst + 4) = (u32x2){w[4], w[5]};
            if (l5 == 0) { const float s_ = am * (1.f / 7.5f); (tb ? SCV : SCU)[e] = s_; ((bf16_t*)SCP)[2 * e + tb] = (bf16_t)(cvt_pk_bf16(s_, s_) & 0xffffu); }
        }
    }
    }
#endif
    GRID_BAR();
    }
#pragma unroll 1
    for (int rep_ = 0; rep_ < (int)((REPMASK >> 10) & 1) + 1; ++rep_) {
#if (PHMASK >> 10) & 1
    { DEF_PTRS
    {
        pg8::Gemm g{YA, Wda, T, 1024, 2048, 1024, 2048, OB, 1024}; pg8::StaticOrder S; S.init(T, 1024, C.G, (int)blockIdx.x);
        pg8::EpiGate2 E{GATES, 2048, MERGED, 1024};
        pg8::gemm_phase<pg8::EpiGate2, true>(C.lds, g, S, E, C.tid);
    }
    }
#endif
    GRID_BAR();
    }
#pragma unroll 1
    for (int rt_ = 0; rt_ < REPTAIL; ++rt_) {
#pragma unroll 1
    for (int rep_ = 0; rep_ < (int)((REPMASK >> 12) & 1) + 1; ++rep_) {
#if (PHMASK >> 12) & 1
    { DEF_PTRS
    {
        pg8::Gemm g{MERGED, Wout, T, 1024, 1024, 1024, 1024}; pg8::StaticOrder S; S.init(T, 1024, C.G, (int)blockIdx.x);
        pg8::EpiResid E{x, out, 1024};
        pg8::gemm_phase<pg8::EpiResid>(C.lds, g, S, E, C.tid);
    }
    }
#endif
    GRID_BAR();
    }
#pragma unroll 1
    for (int rep_ = 0; rep_ < (int)((REPMASK >> 13) & 1) + 1; ++rep_) {
#if (PHMASK >> 13) & 1
    { DEF_PTRS
    for (int m = C.gw; m < T; m += C.NGW) rms_row_f32_to_bf16(out + (size_t)m * 1024, IN(I_FFN_NORM), H2 + (size_t)m * 1024, lane);
    }
#endif
    GRID_BAR();
    }
#pragma unroll 1
    for (int rep_ = 0; rep_ < (int)((REPMASK >> 14) & 1) + 1; ++rep_) {
#if (PHMASK >> 14) & 1
    { DEF_PTRS
    {
        pg8::Gemm g{H2, Wq, T, 2048, 1024, 1024, 1024}; pg8::StaticOrder S; S.init(T, 2048, C.G, (int)blockIdx.x);
        pg8::EpiStore E{QP, 2048, 0, 0, 0, nullptr, 0};
        pg8::gemm_phase<pg8::EpiStore>(C.lds, g, S, E, C.tid);
    }
    }
#endif
    GRID_BAR();
    }
#pragma unroll 1
    for (int rep_ = 0; rep_ < (int)((REPMASK >> 15) & 1) + 1; ++rep_) {
#if (PHMASK >> 15) & 1
    { DEF_PTRS
    p7_topk(C, QP, KEYS, EIDX, GATE);
    }
#endif
    GRID_BAR();
    }
#pragma unroll 1
    for (int rep_ = 0; rep_ < (int)((REPMASK >> 16) & 1) + 1; ++rep_) {
#if (PHMASK >> 16) & 1
    { DEF_PTRS
    p8_gather(C, H2, UT8, VT8, SCP, EIDX, GATE, out);
    }
#endif
    }
    if (rt_ + 1 < REPTAIL) GRID_BAR();
    }
}

extern "C" void kernel_launch(void* const* d_in, const int* in_sizes, int n_in, void* d_out, int out_size, void* d_ws, size_t ws_size, hipStream_t stream) {
    static int grid = 0;
    if (grid == 0) {
        int dev = 0, cus = 0, per_cu = 0;
        (void)hipGetDevice(&dev);
        (void)hipDeviceGetAttribute(&cus, hipDeviceAttributeMultiprocessorCount, dev);
        (void)hipFuncSetAttribute((const void*)mega_fwd, hipFuncAttributeMaxDynamicSharedMemorySize, LDS_BYTES);
        (void)hipOccupancyMaxActiveBlocksPerMultiprocessor(&per_cu, (const void*)mega_fwd, NWAVES * 64, LDS_BYTES);
        if (per_cu < 1) { fprintf(stderr, "kernel_launch: occupancy query says %d\n", per_cu); }
        grid = 256;
        if (cus * per_cu < grid) fprintf(stderr, "kernel_launch: device holds only %d x %d resident workgroups; 256 needed\n", cus, per_cu);
        if (n_in != 25 || out_size != T * D || ws_size < WS_END) fprintf(stderr, "kernel_launch: unexpected n_in %d out %d ws %zu\n", n_in, out_size, ws_size);
    }
    (void)hipMemsetAsync(d_ws, 0, CTL_ZERO_BYTES, stream);
    Args a{};
    for (int i = 0; i < 25 && i < n_in; ++i) a.in[i] = (const float*)d_in[i];
    a.out = (float*)d_out; a.ws = (unsigned char*)d_ws;
    void* kargs[] = {&a};
    hipError_t e = hipLaunchCooperativeKernel((const void*)mega_fwd, dim3(grid), dim3(NWAVES * 64), kargs, LDS_BYTES, stream);
    if (e != hipSuccess) fprintf(stderr, "cooperative launch failed: %s (grid %d)\n", hipGetErrorString(e), grid);
}
```
